# Optimizing an MI355X kernel written in HIP

```python
import math
import jax, jax.numpy as jnp
from jax import lax
import numpy as np

D_MODEL = 1024
BATCH = 8
SEQ = 2048
DEPTH = 4

GRID_W = 64
CTX_LEN = 256
MIX_WIDTH = D_MODEL
S5_WIDTH = (3 * MIX_WIDTH) // 4
FNET_WIDTH = MIX_WIDTH - S5_WIDTH
S5_H = 16
S5_GROUPS = S5_WIDTH // S5_H
S5_P = 64
FNET_GROUPS = 4
FNET_GW = FNET_WIDTH // FNET_GROUPS
POOL_WIDTH = MIX_WIDTH // 2
CONV_WIDTH = MIX_WIDTH - POOL_WIDTH
POOL_WINDOWS = (2, 4, 8, 16)
POOL_GROUPS = len(POOL_WINDOWS)
POOL_GW = POOL_WIDTH // POOL_GROUPS
CONV_K = 3
N_EVEN = (DEPTH + 1) // 2
N_ODD = DEPTH // 2
EVEN_IN = S5_WIDTH + FNET_WIDTH + MIX_WIDTH
ODD_IN = POOL_WIDTH + 3 * CONV_WIDTH + MIX_WIDTH
STEP_MIN = 1e-3
STEP_MAX = 1e-1
EPS = 1e-6
POS_BASE = 10000.0

kernel_name = 'hybrid_s5_fnet_pool_shortconv_prefix'


def rmsnorm(x, g):
    xf = x.astype(jnp.float32)
    y = xf * lax.rsqrt(jnp.mean(xf * xf, axis=-1, keepdims=True) + EPS)
    return (y * g.astype(jnp.float32)).astype(x.dtype)


def ada_params(cond, w, b):
    m = jax.nn.silu(cond) @ w + b
    return jnp.split(m, 3, axis=-1)


def sincos_2d(n_tok, dim):
    rows = n_tok // GRID_W
    r = jnp.arange(rows, dtype=jnp.float32)
    col = jnp.arange(GRID_W, dtype=jnp.float32)
    rr, cc = jnp.meshgrid(r, col, indexing='ij')
    rr = rr.reshape(-1, 1)
    cc = cc.reshape(-1, 1)
    quarter = dim // 4
    omega = POS_BASE ** (-jnp.arange(quarter, dtype=jnp.float32) / quarter)
    return jnp.concatenate([jnp.sin(rr * omega), jnp.cos(rr * omega),
                            jnp.sin(cc * omega), jnp.cos(cc * omega)], axis=-1)


def _linear_recurrence(e1, e2):
    a1, b1 = e1
    a2, b2 = e2
    return a2 * a1, a2 * b1 + b2


def s5_direction(u, lam_re, lam_im, log_step, b_re, b_im, c_re, c_im):
    f32 = jnp.float32
    lam = lax.complex(lam_re.astype(f32), lam_im.astype(f32))
    step = jnp.exp(log_step.astype(f32))[:, None]
    lam_bar = jnp.exp(lam * step)
    b_bar = ((lam_bar - 1.0) / lam)[..., None] * lax.complex(b_re.astype(f32), b_im.astype(f32))
    bu = lax.complex(jnp.einsum('btgh,gph->btgp', u, b_bar.real),
                     jnp.einsum('btgh,gph->btgp', u, b_bar.imag))
    a = jnp.broadcast_to(lam_bar, bu.shape)
    _, s = lax.associative_scan(_linear_recurrence, (a, bu), axis=1)
    return (jnp.einsum('btgp,ghp->btgh', s.real, c_re.astype(f32))
            - jnp.einsum('btgp,ghp->btgh', s.imag, c_im.astype(f32)))


def s5_bidir(u_lat, u_ctx, need_ctx, lam_re, lam_im, log_step, b_re, b_im, c_re, c_im, d_skip):
    bsz, t_lat, _ = u_lat.shape
    t_ctx = u_ctx.shape[1]
    ul = u_lat.astype(jnp.float32).reshape(bsz, t_lat, S5_GROUPS, S5_H)
    uc = u_ctx.astype(jnp.float32).reshape(bsz, t_ctx, S5_GROUPS, S5_H)
    yf = s5_direction(jnp.concatenate([uc, ul], axis=1),
                      lam_re[0], lam_im[0], log_step[0], b_re[0], b_im[0], c_re[0], c_im[0])
    yb = s5_direction(jnp.concatenate([jnp.flip(uc, 1), jnp.flip(ul, 1)], axis=1),
                      lam_re[1], lam_im[1], log_step[1], b_re[1], b_im[1], c_re[1], c_im[1])
    d = d_skip.astype(jnp.float32)
    y_lat = yf[:, t_ctx:] + jnp.flip(yb[:, t_ctx:], 1) + d * ul
    y_lat = y_lat.reshape(bsz, t_lat, S5_WIDTH)
    if not need_ctx:
        return y_lat, None
    y_ctx = yf[:, :t_ctx] + jnp.flip(yb[:, :t_ctx], 1) + d * uc
    return y_lat, y_ctx.reshape(bsz, t_ctx, S5_WIDTH)


def fnet_mix(u, f_w):
    bsz, t, _ = u.shape
    g = u.astype(jnp.float32).reshape(bsz, t, FNET_GROUPS, FNET_GW).transpose(0, 2, 1, 3)
    f = jnp.fft.fft2(g, axes=(-2, -1), norm='ortho').real
    y = jnp.einsum('bgtc,gcd->btgd', f, f_w.astype(jnp.float32))
    return y.reshape(bsz, t, FNET_WIDTH)


def even_branch_out(ya, ub, z, glu_w, glu_b, f_w, w_out):
    ya = jax.nn.gelu(ya)
    ya = ya * jax.nn.sigmoid(ya @ glu_w.astype(jnp.float32) + glu_b.astype(jnp.float32))
    yb = fnet_mix(ub, f_w)
    y = jnp.concatenate([ya, yb], axis=-1).astype(z.dtype) * jax.nn.silu(z)
    return y @ w_out


def even_mixer(hl, hc, need_ctx, w_in, w_out, lam_re, lam_im, log_step, b_re, b_im,
               c_re, c_im, d_skip, glu_w, glu_b, f_w):
    pl = hl @ w_in
    pc = hc @ w_in if need_ctx else hc @ w_in[:, :S5_WIDTH]
    ya_l, ya_c = s5_bidir(pl[..., :S5_WIDTH], pc[..., :S5_WIDTH], need_ctx,
                          lam_re, lam_im, log_step, b_re, b_im, c_re, c_im, d_skip)
    out_l = even_branch_out(ya_l, pl[..., S5_WIDTH:MIX_WIDTH], pl[..., MIX_WIDTH:],
                            glu_w, glu_b, f_w, w_out)
    if not need_ctx:
        return out_l, None
    out_c = even_branch_out(ya_c, pc[..., S5_WIDTH:MIX_WIDTH], pc[..., MIX_WIDTH:],
                            glu_w, glu_b, f_w, w_out)
    return out_l, out_c


def centered_mean(v, window):
    bsz, t, ch = v.shape
    s = jnp.concatenate([jnp.zeros((bsz, 1, ch), v.dtype), jnp.cumsum(v, axis=1)], axis=1)
    pos = jnp.arange(t)
    lo = jnp.clip(pos - window // 2, 0, t)
    hi = jnp.clip(pos + window // 2, 0, t)
    total = jnp.take(s, hi, axis=1) - jnp.take(s, lo, axis=1)
    return total / (hi - lo).astype(v.dtype)[None, :, None]


def pool_mix(u, p_w, p_scale):
    bsz, t, _ = u.shape
    g = u.astype(jnp.float32).reshape(bsz, t, POOL_GROUPS, POOL_GW)
    pooled = jnp.stack([centered_mean(g[:, :, i], POOL_WINDOWS[i]) - g[:, :, i]
                        for i in range(POOL_GROUPS)], axis=2)
    y = jnp.einsum('btgc,gcd->btgd', pooled, p_w.astype(jnp.float32)).reshape(bsz, t, POOL_WIDTH)
    return (y * p_scale.astype(jnp.float32)).astype(u.dtype)


def short_conv(v, w):
    return lax.conv_general_dilated(v, w[:, None, :].astype(v.dtype), window_strides=(1,),
                                    padding=[(CONV_K // 2, CONV_K // 2)],
                                    dimension_numbers=('NWC', 'WIO', 'NWC'),
                                    feature_group_count=v.shape[-1])


def odd_mixer(h, w_in, w_out, p_w, p_scale, conv_w):
    p = h @ w_in
    o1 = POOL_WIDTH
    o2 = o1 + CONV_WIDTH
    o3 = o2 + CONV_WIDTH
    o4 = o3 + CONV_WIDTH
    y_c = pool_mix(p[..., :o1], p_w, p_scale)
    c_gate, x_path, b_gate, z = p[..., o1:o2], p[..., o2:o3], p[..., o3:o4], p[..., o4:]
    y_d = b_gate * short_conv(c_gate * x_path, conv_w)
    y = jnp.concatenate([y_c, y_d], axis=-1) * jax.nn.silu(z)
    return y @ w_out


def setup_inputs(seed: int = 0) -> dict:
    key = jax.random.key(seed)
    ks = jax.random.split(key, 26)
    f32 = jnp.float32
    D = D_MODEL

    def nrm(k, shape, s):
        return jax.random.normal(k, shape, f32) * s

    s5_state_shape = (N_EVEN, 2, S5_GROUPS, S5_P)
    return {
        'x': nrm(ks[0], (BATCH, SEQ, D), 1.0),
        'c': nrm(ks[1], (BATCH, D), 1.0),
        'ctx': nrm(ks[2], (BATCH, CTX_LEN, D), 1.0),
        'c_ctx': nrm(ks[3], (D,), 1.0),
        'norm_g': 1.0 + nrm(ks[4], (DEPTH, D), 0.02),
        'ada_w': nrm(ks[5], (DEPTH, D, 3 * D), 0.5 * D ** -0.5),
        'ada_b': nrm(ks[6], (DEPTH, 3 * D), 0.02),
        'even_w_in': nrm(ks[7], (N_EVEN, D, EVEN_IN), D ** -0.5),
        'even_w_out': nrm(ks[8], (N_EVEN, MIX_WIDTH, D), MIX_WIDTH ** -0.5),
        's5_lam_re': -0.5 + nrm(ks[9], s5_state_shape, 0.01),
        's5_lam_im': jnp.pi * jnp.arange(S5_P, dtype=f32) + nrm(ks[10], s5_state_shape, 0.01),
        's5_log_step': jax.random.uniform(ks[11], (N_EVEN, 2, S5_GROUPS), f32,
                                          math.log(STEP_MIN), math.log(STEP_MAX)),
        's5_b_re': nrm(ks[12], (N_EVEN, 2, S5_GROUPS, S5_P, S5_H), (2 * S5_H) ** -0.5),
        's5_b_im': nrm(ks[13], (N_EVEN, 2, S5_GROUPS, S5_P, S5_H), (2 * S5_H) ** -0.5),
        's5_c_re': nrm(ks[14], (N_EVEN, 2, S5_GROUPS, S5_H, S5_P), S5_P ** -0.5),
        's5_c_im': nrm(ks[15], (N_EVEN, 2, S5_GROUPS, S5_H, S5_P), S5_P ** -0.5),
        's5_d': 1.0 + nrm(ks[16], (N_EVEN, S5_GROUPS, S5_H), 0.1),
        's5_glu_w': nrm(ks[17], (N_EVEN, S5_WIDTH, S5_WIDTH), S5_WIDTH ** -0.5),
        's5_glu_b': nrm(ks[18], (N_EVEN, S5_WIDTH), 0.02),
        'fnet_w': nrm(ks[19], (N_EVEN, FNET_GROUPS, FNET_GW, FNET_GW), FNET_GW ** -0.5),
        'odd_w_in': nrm(ks[20], (N_ODD, D, ODD_IN), D ** -0.5),
        'odd_w_out': nrm(ks[21], (N_ODD, MIX_WIDTH, D), MIX_WIDTH ** -0.5),
        'pool_w': nrm(ks[22], (N_ODD, POOL_GROUPS, POOL_GW, POOL_GW), POOL_GW ** -0.5),
        'pool_scale': 1.0 + nrm(ks[23], (N_ODD, POOL_WIDTH), 0.1),
        'conv_w': nrm(ks[24], (N_ODD, CONV_K, CONV_WIDTH), CONV_K ** -0.5),
        'final_g': 1.0 + nrm(ks[25], (D,), 0.02),
    }


def reference(x, c, ctx, c_ctx, norm_g, ada_w, ada_b, even_w_in, even_w_out,
              s5_lam_re, s5_lam_im, s5_log_step, s5_b_re, s5_b_im, s5_c_re, s5_c_im,
              s5_d, s5_glu_w, s5_glu_b, fnet_w, odd_w_in, odd_w_out, pool_w,
              pool_scale, conv_w, final_g):
    n_tok = x.shape[1]
    xl = x + sincos_2d(n_tok, x.shape[-1]).astype(x.dtype)[None]
    xc = ctx
    need_ctx = [any(j % 2 == 0 for j in range(l + 1, DEPTH)) for l in range(DEPTH)]
    for l in range(DEPTH):
        i = l // 2
        shift, scale, gate = ada_params(c, ada_w[l], ada_b[l])
        hl = rmsnorm(xl, norm_g[l]) * (1.0 + scale[:, None]) + shift[:, None]
        use_ctx_in = (l % 2 == 0) or need_ctx[l]
        if use_ctx_in:
            shift_c, scale_c, gate_c = ada_params(c_ctx, ada_w[l], ada_b[l])
            hc = rmsnorm(xc, norm_g[l]) * (1.0 + scale_c) + shift_c
        if l % 2 == 0:
            out_l, out_c = even_mixer(hl, hc, need_ctx[l], even_w_in[i], even_w_out[i],
                                      s5_lam_re[i], s5_lam_im[i], s5_log_step[i],
                                      s5_b_re[i], s5_b_im[i], s5_c_re[i], s5_c_im[i],
                                      s5_d[i], s5_glu_w[i], s5_glu_b[i], fnet_w[i])
        else:
            out_l = odd_mixer(hl, odd_w_in[i], odd_w_out[i], pool_w[i], pool_scale[i], conv_w[i])
            out_c = (odd_mixer(hc, odd_w_in[i], odd_w_out[i], pool_w[i], pool_scale[i], conv_w[i])
                     if need_ctx[l] else None)
        xl = xl + gate[:, None] * out_l.astype(xl.dtype)
        if need_ctx[l]:
            xc = xc + gate_c * out_c.astype(xc.dtype)
    return rmsnorm(xl, final_g)
```

```cpp
#include <hip/hip_runtime.h>
#include <cstdio>
#include <cstdint>

#ifndef MK_ONE_LAUNCH
#define MK_ONE_LAUNCH 1
#endif

#define LAS __attribute__((address_space(3)))
#define GAS __attribute__((address_space(1)))
typedef _Float16 h16;
typedef _Float16 h16x8 __attribute__((ext_vector_type(8)));
typedef _Float16 h16x4 __attribute__((ext_vector_type(4)));
typedef _Float16 h16x2 __attribute__((ext_vector_type(2)));
typedef float f32x4 __attribute__((ext_vector_type(4)));
typedef float f32x2 __attribute__((ext_vector_type(2)));
typedef unsigned u32x4 __attribute__((ext_vector_type(4)));
typedef unsigned u32x2 __attribute__((ext_vector_type(2)));
typedef GAS unsigned gu32;

constexpr int NB = 8, T = 2048, TC = 256, D = 1024;
constexpr int NLAT = NB * T, NCTX = NB * TC, NTOK = NLAT + NCTX;
constexpr int NGRP = 48;
constexpr int UA_ROWS = 1280, UA_LD = 512;
constexpr float SIG1 = 64.f, SIG2 = 1024.f;
constexpr int N_PHASES = 24;

constexpr size_t al256(size_t x) { return (x + 255) & ~size_t(255); }
constexpr size_t WS_CTL = 0, CTL_BYTES = 1u << 20;
constexpr size_t WS_ADA = WS_CTL + CTL_BYTES;
constexpr size_t WS_POS = WS_ADA + al256(4 * 9 * 3072 * 4);
constexpr size_t WS_LAM = WS_POS + al256(96 * 512 * 4);
constexpr size_t WS_WB = WS_LAM + al256(2 * 2 * 48 * 64 * 8);
constexpr size_t WS_XC = WS_WB + al256(256 * 512 * 2);
constexpr size_t WS_H = WS_XC + al256((size_t)NCTX * D * 4);
constexpr size_t WS_SZ = WS_H + al256((size_t)NTOK * D * 2);
constexpr size_t WS_TMP = WS_SZ + al256((size_t)NTOK * D * 2);
constexpr size_t WS_UA = WS_TMP;
constexpr size_t WS_ZT = WS_UA + al256((size_t)NGRP * UA_ROWS * UA_LD * 2);
constexpr size_t WS_YB = WS_ZT + al256((size_t)512 * NLAT * 2);
constexpr size_t WS_YA = WS_ZT;
constexpr size_t WS_P = WS_TMP;
constexpr size_t TMP_BYTES = al256((size_t)NGRP * UA_ROWS * UA_LD * 2) + al256((size_t)512 * NLAT * 2) + al256((size_t)NTOK * 512 * 2);
static_assert((size_t)NTOK * 768 * 2 <= al256((size_t)512 * NLAT * 2) + al256((size_t)NTOK * 512 * 2), "YA alias");
static_assert((size_t)NTOK * 2048 * 2 <= TMP_BYTES, "P alias");
constexpr size_t WS_W = WS_TMP + TMP_BYTES;
constexpr size_t SZ_WEIN = (size_t)1792 * 1024 * 2, SZ_WZ = (size_t)512 * 1024 * 2, SZ_WGLU = (size_t)768 * 768 * 2, SZ_WOUT = (size_t)1024 * 1024 * 2;
constexpr size_t SZ_WOIN = (size_t)3072 * 1024 * 2, SZ_W1 = (size_t)NGRP * 256 * 256 * 2, SZ_W2 = (size_t)NGRP * 256 * 512 * 2;
constexpr size_t WS_WEIN = WS_W, WS_WZ = WS_WEIN + 2 * SZ_WEIN, WS_WGLU = WS_WZ + 2 * SZ_WZ, WS_WEOUT = WS_WGLU + 2 * SZ_WGLU, WS_WOIN = WS_WEOUT + 2 * SZ_WOUT;
constexpr size_t WS_WOOUT = WS_WOIN + 2 * SZ_WOIN, WS_W1 = WS_WOOUT + 2 * SZ_WOUT, WS_W2 = WS_W1 + 2 * SZ_W1, WS_END = WS_W2 + 2 * SZ_W2;
static_assert(WS_END <= (size_t)268435456, "workspace map exceeds 256 MiB");

constexpr int RING_BYTES = 131072, MISC_OFF = RING_BYTES, LDS_BYTES = 147456;

__device__ __forceinline__ unsigned pkh(float lo, float hi) { h16x2 v; v.x = (h16)lo; v.y = (h16)hi; return __builtin_bit_cast(unsigned, v); }
__device__ __forceinline__ f32x2 unpkh(unsigned w) { h16x2 v = __builtin_bit_cast(h16x2, w); return (f32x2){(float)v.x, (float)v.y}; }
__device__ __forceinline__ float sigmoidf_(float x) { return __builtin_amdgcn_rcpf(1.0f + __expf(-x)); }
__device__ __forceinline__ float siluf_(float x) { return x * sigmoidf_(x); }
__device__ __forceinline__ float gelu_tanh_(float x) { const float u = 0.7978845608028654f * (x + 0.044715f * x * x * x); return x * sigmoidf_(2.0f * u); }
#define SWZ_XOR(v, k) __builtin_bit_cast(float, __builtin_amdgcn_ds_swizzle(__builtin_bit_cast(int, (float)(v)), 0x1f | ((k) << 10)))
__device__ __forceinline__ float xor32(float v, int lane) { return __builtin_bit_cast(float, __builtin_amdgcn_ds_bpermute((lane ^ 32) << 2, __builtin_bit_cast(int, v))); }
__device__ __forceinline__ float wave_sum(float v, int lane) {
    v += SWZ_XOR(v, 1); v += SWZ_XOR(v, 2); v += SWZ_XOR(v, 4); v += SWZ_XOR(v, 8); v += SWZ_XOR(v, 16);
    return v + xor32(v, lane);
}
#define LDS_WAIT() asm volatile("s_waitcnt lgkmcnt(0)" ::: "memory")
#define VM_WAIT() asm volatile("s_waitcnt vmcnt(0)" ::: "memory")

namespace pg8 {
constexpr int BM = 256, BK = 64, HALF = 128, HTB = HALF * BK * 2, STAGE_BYTES = 8 * HTB;
__device__ __forceinline__ int lds_byte(int r, int c) { const int st = (r >> 4) * 2 + (c >> 5), rr = r & 15, cc = c & 31, ob = rr * 64 + cc * 2; return st * 1024 + (ob ^ (((ob >> 9) & 1) << 5)); }
__device__ __forceinline__ void stage_rc(int b, int& R, int& C) { const int st = b / 1024, sb = b % 1024, swz = sb ^ (((sb >> 9) & 1) << 5); R = (st >> 1) * 16 + swz / 64; C = (st & 1) * 32 + (swz % 64) / 2; }
__device__ __forceinline__ int perm32(int rho) { const int n = rho >> 4, i = rho & 15; return 8 * (i >> 2) + 4 * n + (i & 3); }
struct Unit { const char* a; const char* b; int job, pm, pn, aux; };
typedef f32x4 Acc[2][2][4][2];

template <class Epi, class Sched>
__device__ __forceinline__ void gemm_phase(LAS unsigned char* lds, const int tid, const int K, const int lda, const int ldb, const Sched& S, const Epi& E) {
    const int wid = __builtin_amdgcn_readfirstlane(tid >> 6), lane = tid & 63, wr = wid >> 2, wc = wid & 3, fr = lane & 15, fq = lane >> 4;
    int nt = K / BK; asm volatile("" : "+s"(nt));
    unsigned voffA[2], voffB[2];
#pragma unroll
    for (int i = 0; i < 2; ++i) { int R, C; stage_rc(tid * 16 + i * 8192, R, C); const int Rb = (R & ~31) + perm32(R & 31);
        voffA[i] = (unsigned)(R * lda + C) * 2u; voffB[i] = (unsigned)(Rb * ldb + C) * 2u; }
    const size_t kstep = (size_t)(BK * 2);
    const size_t hstepA = (size_t)HALF * lda * 2, hstepB = (size_t)HALF * ldb * 2;
    const unsigned ldsw = (unsigned)wid * 1024u;
    const int aoff = lds_byte(wr * 64 + fr, fq * 8), boff = lds_byte(wc * 32 + fr, fq * 8);
#define PG8_SA(b, h) (((b) * 2 + (h)) * HTB)
#define PG8_SB(b, h) ((4 + (b) * 2 + (h)) * HTB)
#define PG8_STAGE(bufoff, gbase, voff) do { _Pragma("unroll") for (int _i = 0; _i < 2; ++_i) \
        __builtin_amdgcn_global_load_lds((const unsigned*)((const char*)(gbase) + (voff)[_i]), (LAS unsigned*)(lds + (bufoff) + ldsw + _i * 8192), 16, 0, 0); } while (0)
#define PG8_LDA(dst, b, h) do { _Pragma("unroll") for (int m = 0; m < 4; ++m) _Pragma("unroll") for (int k = 0; k < 2; ++k) dst[m][k] = *(const LAS h16x8*)(lds + PG8_SA(b, h) + aoff + m * 2048 + k * 1024); } while (0)
#define PG8_LDB(dst, b, h) do { _Pragma("unroll") for (int n = 0; n < 2; ++n) _Pragma("unroll") for (int k = 0; k < 2; ++k) dst[n][k] = *(const LAS h16x8*)(lds + PG8_SB(b, h) + boff + n * 2048 + k * 1024); } while (0)
#define PG8_MMA(ai, bj, At, Bt) do { __builtin_amdgcn_s_setprio(1); _Pragma("unroll") for (int m = 0; m < 4; ++m) _Pragma("unroll") for (int n = 0; n < 2; ++n) _Pragma("unroll") for (int k = 0; k < 2; ++k) \
        acc[ai][bj][m][n] = __builtin_amdgcn_mfma_f32_16x16x32_f16(Bt[n][k], At[m][k], acc[ai][bj][m][n], 0, 0, 0); __builtin_amdgcn_s_setprio(0); } while (0)
#define PG8_WAIT_V(n) asm volatile("s_waitcnt vmcnt(" #n ")" ::: "memory")
#define PG8_WAIT_L(n) asm volatile("s_waitcnt lgkmcnt(" #n ")" ::: "memory")
#define PG8_BAR __builtin_amdgcn_s_barrier()
#define PG8_SCHED __builtin_amdgcn_sched_barrier(0)
    Unit cur, nxt; int ui = 0;
    if (!S.next(0, cur)) return;
    Acc acc;
#pragma unroll
    for (int a = 0; a < 2; ++a)
#pragma unroll
        for (int b = 0; b < 2; ++b)
#pragma unroll
            for (int m = 0; m < 4; ++m)
#pragma unroll
                for (int n = 0; n < 2; ++n) acc[a][b][m][n] = (f32x4){0.f, 0.f, 0.f, 0.f};
    h16x8 At[4][2], B0[2][2], B1[2][2];
    const char* cA = cur.a; const char* cB = cur.b;
    PG8_STAGE(PG8_SB(0, 0), cB, voffB); PG8_STAGE(PG8_SB(0, 1), cB + hstepB, voffB); PG8_STAGE(PG8_SA(0, 0), cA, voffA); PG8_STAGE(PG8_SA(0, 1), cA + hstepA, voffA);
    if (wr == 1) PG8_BAR;
    PG8_WAIT_V(2); PG8_BAR;
    PG8_STAGE(PG8_SB(1, 0), cB + kstep, voffB); PG8_STAGE(PG8_SA(1, 0), cA + kstep, voffA); PG8_STAGE(PG8_SB(1, 1), cB + hstepB + kstep, voffB);
    PG8_WAIT_V(6); PG8_BAR;
    for (;;) {
        const bool has_next = S.next(ui + 1, nxt);
        const char* nA = has_next ? nxt.a : cA; const char* nB = has_next ? nxt.b : cB;
        for (int t = 0; t < nt; t += 2) {
            const bool last = (t == nt - 2);
            const char* a1 = cA + (size_t)(t + 1) * kstep;
            const char* a2 = last ? nA : cA + (size_t)(t + 2) * kstep; const char* b2 = last ? nB : cB + (size_t)(t + 2) * kstep;
            const char* a3 = a2 + kstep; const char* b3 = b2 + kstep;
            PG8_LDB(B0, 0, 0); PG8_LDB(B1, 0, 1); PG8_SCHED; PG8_LDA(At, 0, 0); PG8_STAGE(PG8_SA(1, 1), a1 + hstepA, voffA);
            PG8_WAIT_V(8); PG8_WAIT_L(0); PG8_BAR; PG8_MMA(0, 0, At, B0); PG8_MMA(0, 1, At, B1); PG8_BAR; PG8_SCHED;
            PG8_LDA(At, 0, 1); PG8_STAGE(PG8_SB(0, 0), b2, voffB); PG8_STAGE(PG8_SB(0, 1), b2 + hstepB, voffB); PG8_STAGE(PG8_SA(0, 0), a2, voffA);
            PG8_WAIT_V(8); PG8_WAIT_L(0); PG8_BAR; PG8_MMA(1, 0, At, B0); PG8_MMA(1, 1, At, B1); PG8_BAR; PG8_SCHED;
            PG8_LDB(B0, 1, 0); PG8_LDB(B1, 1, 1); PG8_SCHED; PG8_LDA(At, 1, 0); PG8_STAGE(PG8_SA(0, 1), a2 + hstepA, voffA);
            PG8_WAIT_V(8); PG8_WAIT_L(0); PG8_BAR; PG8_MMA(0, 0, At, B0); PG8_MMA(0, 1, At, B1); PG8_BAR; PG8_SCHED;
            PG8_LDA(At, 1, 1); PG8_STAGE(PG8_SB(1, 0), b3, voffB); PG8_STAGE(PG8_SB(1, 1), b3 + hstepB, voffB); PG8_STAGE(PG8_SA(1, 0), a3, voffA);
            PG8_WAIT_V(8); PG8_WAIT_L(0); PG8_BAR; PG8_MMA(1, 0, At, B0); PG8_MMA(1, 1, At, B1); PG8_BAR; PG8_SCHED;
        }
        if (wr == 0) PG8_BAR;
        E(acc, cur, wr, wc, fr, fq);
        if (!has_next) break;
#pragma unroll
        for (int a = 0; a < 2; ++a)
#pragma unroll
            for (int b = 0; b < 2; ++b)
#pragma unroll
                for (int m = 0; m < 4; ++m)
#pragma unroll
                    for (int n = 0; n < 2; ++n) acc[a][b][m][n] = (f32x4){0.f, 0.f, 0.f, 0.f};
        cur = nxt; cA = nA; cB = nB; ++ui;
        if (wr == 1) PG8_BAR;
    }
    PG8_WAIT_V(0);
    PG8_BAR;
#undef PG8_SA
#undef PG8_SB
#undef PG8_STAGE
#undef PG8_LDA
#undef PG8_LDB
#undef PG8_MMA
#undef PG8_WAIT_V
#undef PG8_WAIT_L
#undef PG8_BAR
#undef PG8_SCHED
}
__device__ __forceinline__ int xcd_remap(int L, int nwg) { const int q = nwg / 8, r = nwg % 8, xcd = L % 8, off = L / 8; return (xcd < r ? xcd * (q + 1) : r * (q + 1) + (xcd - r) * q) + off; }
__device__ __forceinline__ void tile_of(int wgid, int nM, int nN, int& pm, int& pn) { const int nig = 8 * nN, gid = wgid / nig, fm = gid * 8, gsz = (nM - fm) < 8 ? (nM - fm) : 8; pm = fm + ((wgid % nig) % gsz); pn = (wgid % nig) / gsz; }
}
using pg8::Unit; using pg8::Acc;

#define XB_TMO      128
#define XB_XCNT(j)  (256  + 64 * (j))
#define XB_XSUB(j)  (1280 + 64 * (j))
#define XB_XGEN(j)  (2304 + 64 * (j))
#define XB_TOP      3328
#define XB_TOPGEN   3392
#define XCD_BAR_WORDS 3456
#define XB_SPIN_CAP (1u << 20)
__device__ __forceinline__ unsigned xb_ld(unsigned* p)              { return __hip_atomic_load(p, __ATOMIC_RELAXED, __HIP_MEMORY_SCOPE_AGENT); }
__device__ __forceinline__ unsigned xb_add(unsigned* p, unsigned v) { return __hip_atomic_fetch_add(p, v, __ATOMIC_RELAXED, __HIP_MEMORY_SCOPE_AGENT); }
__device__ __forceinline__ unsigned xb_xcc_id() { return (unsigned)__builtin_amdgcn_s_getreg((3 << 11) | 20) & 0xFu; }
#define XB_SPIN(cond, bar) do { unsigned _sp = 0; while (cond) { __builtin_amdgcn_s_sleep(1); \
    if ((++_sp & 255u) == 0u) { if (xb_ld(&(bar)[XB_TMO])) break; if (_sp > XB_SPIN_CAP) { atomicAdd(&(bar)[XB_TMO], 1u); break; } } } } while (0)
struct XcdBarrier { unsigned* bar; unsigned x; volatile LAS unsigned* st; };
__device__ __forceinline__ XcdBarrier xcd_barrier_post(unsigned* bar, volatile LAS unsigned* st, bool t0) {
    XcdBarrier b; b.bar = bar; b.x = xb_xcc_id(); b.st = st;
    if (t0) (void)xb_add(&bar[XB_XCNT(b.x)], 1u);
    return b;
}
__device__ __forceinline__ void xcd_barrier_complete(unsigned* bar, unsigned x, unsigned& nloc, unsigned& nx) {
    const unsigned G = gridDim.x * gridDim.y * gridDim.z;
    unsigned sum, cnt, mine, sp = 0u;
    for (;;) {
        sum = 0u; cnt = 0u; mine = 0u;
#pragma unroll
        for (unsigned j = 0; j < 16; ++j) { const unsigned c = xb_ld(&bar[XB_XCNT(j)]); sum += c; cnt += (c > 0u) ? 1u : 0u; mine = (j == x) ? c : mine; }
        if (sum == G) break;
        __builtin_amdgcn_s_sleep(1);
        if ((++sp & 255u) == 0u) { if (xb_ld(&bar[XB_TMO])) break; if (sp > XB_SPIN_CAP) { atomicAdd(&bar[XB_TMO], 1u); break; } }
    }
    nloc = mine > 0u ? mine : 1u; nx = cnt > 0u ? cnt : 1u;
}
__device__ __forceinline__ void xcd_barrier(const XcdBarrier& b, bool t0) {
    asm volatile("s_waitcnt vmcnt(0)" ::: "memory");
    __syncthreads();
    if (t0) {
        unsigned* bar = b.bar;
        __builtin_amdgcn_s_waitcnt(0);
        unsigned nloc = b.st[0], nx = b.st[1];
        if (nloc == 0u) { xcd_barrier_complete(bar, b.x, nloc, nx); b.st[0] = nloc; b.st[1] = nx; }
        const unsigned old = xb_add(&bar[XB_XSUB(b.x)], 1u);
        const unsigned gen = old / nloc;
        if (old + 1u == (gen + 1u) * nloc) {
            __builtin_amdgcn_fence(__ATOMIC_RELEASE, "agent");
            asm volatile("s_waitcnt vmcnt(0)" ::: "memory");
            const unsigned og = xb_add(&bar[XB_TOP], 1u);
            const unsigned tg = og / nx;
            if (og + 1u == (tg + 1u) * nx) xb_add(&bar[XB_TOPGEN], 1u);
            else XB_SPIN(xb_ld(&bar[XB_TOPGEN]) == tg, bar);
            __builtin_amdgcn_fence(__ATOMIC_ACQUIRE, "agent");
            xb_add(&bar[XB_XGEN(b.x)], 1u);
            asm volatile("s_waitcnt vmcnt(0)" ::: "memory");
        } else {
            XB_SPIN(xb_ld(&bar[XB_XGEN(b.x)]) == gen, bar);
            __builtin_amdgcn_fence(__ATOMIC_ACQUIRE, "agent");
            asm volatile("s_waitcnt vmcnt(0)" ::: "memory");
        }
    }
    __syncthreads();
}

struct Params { const float* in[26]; float* out; unsigned char* ws; int ph_lo, ph_hi; };
enum { I_X = 0, I_C, I_CTX, I_CCTX, I_NORMG, I_ADAW, I_ADAB, I_EWIN, I_EWOUT, I_LAMRE, I_LAMIM, I_LOGSTEP, I_BRE, I_BIM, I_CRE, I_CIM, I_S5D, I_GLUW, I_GLUB, I_FNETW,
       I_OWIN, I_OWOUT, I_POOLW, I_POOLS, I_CONVW, I_FINALG };
struct Frame {
    LAS unsigned char* lds;
    int tid, lane, wave, vcu, G, bx;
    const Params* p;
    unsigned char* ws;
};
#define WSP(T, off) ((T*)(F.ws + (off)))

__device__ __forceinline__ void p0_transpose_item(const float* W, int K, int N, int n_src0, int nblk, h16* WT, int row_off, LAS float* scr, int item, int lane) {
    const int kb = item / nblk, nb = item % nblk, k0 = 64 * kb, n0 = 32 * nb;
#pragma unroll 8
    for (int i = 0; i < 32; ++i) { const int kk = 2 * i + (lane >> 5); scr[kk * 33 + (lane & 31)] = W[(size_t)(k0 + kk) * N + n_src0 + n0 + (lane & 31)]; }
    LDS_WAIT(); asm volatile("" ::: "memory");
    const int c = lane & 7;
#pragma unroll
    for (int j = 0; j < 4; ++j) { const int n = (lane >> 3) + 8 * j; const LAS float* s = scr + (8 * c) * 33 + n;
        u32x4 o; o.x = pkh(s[0 * 33], s[1 * 33]); o.y = pkh(s[2 * 33], s[3 * 33]); o.z = pkh(s[4 * 33], s[5 * 33]); o.w = pkh(s[6 * 33], s[7 * 33]);
        *(u32x4*)(WT + (size_t)(row_off + n0 + n) * K + k0 + 8 * c) = o; }
    LDS_WAIT(); asm volatile("" ::: "memory");
}
typedef f32x2 cf;
__device__ __forceinline__ cf cmul(cf a, cf b) { return (cf){a.x * b.x - a.y * b.y, a.x * b.y + a.y * b.x}; }
__device__ __forceinline__ cf lam_pow(float lr, float li, float step, int m) {
    const float mag = expf(lr * step * (float)m);
    const double ang = (double)li * (double)step * (double)m * 0.15915494309189535;
    const double fr = ang - __builtin_rint(ang);
    float s, c; sincospif((float)(2.0 * fr), &s, &c);
    return (cf){mag * c, mag * s};
}
__device__ __forceinline__ cf zoh_coef(float lr, float li, float step, cf lamb) {
    const cf z = (cf){lr * step, li * step};
    const float az2 = z.x * z.x + z.y * z.y;
    if (az2 < 0.0625f) {
        cf acc = (cf){1.f, 0.f}, term = (cf){1.f, 0.f};
#pragma unroll
        for (int n = 2; n <= 10; ++n) { term = cmul(term, z) * (1.0f / n); acc += term; }
        return acc * step;
    }
    const cf num = (cf){lamb.x - 1.0f, lamb.y};
    const float den = 1.0f / (lr * lr + li * li);
    return (cf){(num.x * lr + num.y * li) * den, (num.y * lr - num.x * li) * den};
}
__device__ __forceinline__ void p0_s5_item(Frame& F, int i, int g) {
    const Params& P = *F.p;
    LAS cf* pw = (LAS cf*)(F.lds);
    LAS cf* bb = (LAS cf*)(F.lds + 17408);
    LAS cf* cc = (LAS cf*)(F.lds + 17408 + 16384);
    LAS float* kt = (LAS float*)(F.lds + 17408 + 32768);
    const int tid = F.tid;
    const size_t sgp = ((size_t)i * 2) * NGRP * 64;
    for (int e = tid; e < 2 * 17 * 64; e += 512) { const int dir = e / (17 * 64), m = (e / 64) % 17, p = e & 63;
        const size_t ix = sgp + ((size_t)dir * NGRP + g) * 64 + p;
        const float step = expf(P.in[I_LOGSTEP][((size_t)i * 2 + dir) * NGRP + g]);
        pw[e] = lam_pow(P.in[I_LAMRE][ix], P.in[I_LAMIM][ix], step, m); }
    __syncthreads();
    for (int e = tid; e < 2 * 64 * 16; e += 512) { const int dir = e / 1024, p = (e / 16) & 63, h = e & 15;
        const size_t ix = sgp + ((size_t)dir * NGRP + g) * 64 + p;
        const float step = expf(P.in[I_LOGSTEP][((size_t)i * 2 + dir) * NGRP + g]);
        const cf co = zoh_coef(P.in[I_LAMRE][ix], P.in[I_LAMIM][ix], step, pw[(dir * 17 + 1) * 64 + p]);
        const size_t bx = ix * 16 + h;
        bb[e] = cmul(co, (cf){P.in[I_BRE][bx], P.in[I_BIM][bx]});
        const int ho = (e / 64) & 15, p2 = e & 63;
        const size_t cx = ((((size_t)i * 2 + dir) * NGRP + g) * 16 + ho) * 64 + p2;
        cc[e] = (cf){P.in[I_CRE][cx], P.in[I_CIM][cx]}; }
    __syncthreads();
    {
        const int dir = tid >> 8, ho = (tid >> 4) & 15, hi = tid & 15;
        float kacc[16];
#pragma unroll
        for (int m = 0; m < 16; ++m) kacc[m] = 0.f;
        for (int p = 0; p < 64; ++p) { const cf q = cmul(cc[(dir * 16 + ho) * 64 + p], bb[(dir * 64 + p) * 16 + hi]);
#pragma unroll
            for (int m = 0; m < 16; ++m) { const cf w = pw[(dir * 17 + m) * 64 + p]; kacc[m] += q.x * w.x - q.y * w.y; } }
#pragma unroll
        for (int m = 0; m < 16; ++m) kt[((dir * 16 + m) * 16 + ho) * 16 + hi] = kacc[m];
    }
    __syncthreads();
    h16* W1 = WSP(h16, WS_W1 + (size_t)i * SZ_W1) + (size_t)g * 256 * 256;
    h16* W2 = WSP(h16, WS_W2 + (size_t)i * SZ_W2) + (size_t)g * 256 * 512;
    const float* dsk = P.in[I_S5D] + ((size_t)i * NGRP + g) * 16;
    for (int e = tid; e < 256 * 32; e += 512) { const int n = e >> 5, k0 = (e & 31) * 8, dir = n >> 7, p = (n & 127) >> 1, ri = n & 1, j = k0 >> 4, h0 = k0 & 15;
        const cf w = pw[(dir * 17 + (dir == 0 ? 15 - j : j)) * 64 + p]; float v[8];
#pragma unroll
        for (int q = 0; q < 8; ++q) { const cf t = cmul(w, bb[(dir * 64 + p) * 16 + h0 + q]); v[q] = SIG1 * (ri ? t.y : t.x); }
        u32x4 o; o.x = pkh(v[0], v[1]); o.y = pkh(v[2], v[3]); o.z = pkh(v[4], v[5]); o.w = pkh(v[6], v[7]);
        *(u32x4*)(W1 + (size_t)n * 256 + k0) = o; }
    for (int e = tid; e < 256 * 64; e += 512) { const int n = e >> 6, c0 = (e & 63) * 8, k = n >> 4, ho = n & 15; float v[8];
        if (c0 < 256) { const int j = c0 >> 4, hi0 = c0 & 15;
#pragma unroll
            for (int q = 0; q < 8; ++q) { const int hi = hi0 + q; float x;
                if (k > j) x = kt[((0 * 16 + (k - j)) * 16 + ho) * 16 + hi];
                else if (j > k) x = kt[((1 * 16 + (j - k)) * 16 + ho) * 16 + hi];
                else x = kt[((0 * 16 + 0) * 16 + ho) * 16 + hi] + kt[((1 * 16 + 0) * 16 + ho) * 16 + hi] + (ho == hi ? dsk[ho] : 0.f);
                v[q] = SIG2 * x; }
        } else { const int dir = (c0 - 256) >> 7, p0 = ((c0 - 256) & 127) >> 1, m = (dir == 0) ? k + 1 : 16 - k;
#pragma unroll
            for (int q = 0; q < 4; ++q) { const cf t = cmul(cc[(dir * 16 + ho) * 64 + p0 + q], pw[(dir * 17 + m) * 64 + p0 + q]);
                v[2 * q] = (SIG2 / SIG1) * t.x; v[2 * q + 1] = -(SIG2 / SIG1) * t.y; } }
        u32x4 o; o.x = pkh(v[0], v[1]); o.y = pkh(v[2], v[3]); o.z = pkh(v[4], v[5]); o.w = pkh(v[6], v[7]);
        *(u32x4*)(W2 + (size_t)n * 512 + c0) = o; }
    if (tid < 128) { const int dir = tid >> 6, p = tid & 63; const cf w = pw[(dir * 17 + 16) * 64 + p];
        WSP(f32x2, WS_LAM)[(((size_t)i * 2 + dir) * NGRP + g) * 64 + p] = w; }
    __syncthreads();
}
__device__ __forceinline__ void p0_fnet_item(Frame& F, int item) {
    const Params& P = *F.p;
    const int ks = item & 7, g = (item >> 3) & 3, trig = (item >> 5) & 1, i = item >> 6, tid = F.tid;
    LAS float* M = (LAS float*)F.lds;
    LAS float* tab = (LAS float*)(F.lds + 16384);
    if (tid < 64) { float s, c; sincospif((float)tid * (1.0f / 32.0f), &s, &c); tab[tid] = trig ? s : c; }
    __syncthreads();
    const float* fw = P.in[I_FNETW] + ((size_t)i * 4 + g) * 4096;
    for (int e = tid; e < 4096; e += 512) { const int c = e >> 6, d = e & 63; float a = 0.f;
        for (int m = 0; m < 64; ++m) a += tab[(c * m) & 63] * fw[m * 64 + d];
        M[e] = a; }
    __syncthreads();
    const float* w = P.in[I_EWIN] + (size_t)i * 1024 * 2048 + 768 + g * 64;
    const int d = tid & 63, kg = tid >> 6, k0 = ks * 128 + kg * 16;
    float o[16];
#pragma unroll
    for (int q = 0; q < 16; ++q) o[q] = 0.f;
    for (int c = 0; c < 64; ++c) { const float mv = M[c * 64 + d];
#pragma unroll
        for (int q = 0; q < 16; ++q) o[q] += w[(size_t)(k0 + q) * 2048 + c] * mv; }
    h16* dst = WSP(h16, WS_WZ + (size_t)i * SZ_WZ) + (size_t)(trig * 256 + g * 64 + d) * 1024 + k0;
    u32x4 a, b; a.x = pkh(o[0], o[1]); a.y = pkh(o[2], o[3]); a.z = pkh(o[4], o[5]); a.w = pkh(o[6], o[7]);
    b.x = pkh(o[8], o[9]); b.y = pkh(o[10], o[11]); b.z = pkh(o[12], o[13]); b.w = pkh(o[14], o[15]);
    *(u32x4*)dst = a; *(u32x4*)(dst + 8) = b;
    __syncthreads();
}
__device__ __forceinline__ void p0_pool_item(Frame& F, int item) {
    const Params& P = *F.p;
    const int ks = item & 7, g = (item >> 3) & 3, i = item >> 5, tid = F.tid;
    LAS float* pwl = (LAS float*)F.lds;
    const float* pwg = P.in[I_POOLW] + ((size_t)i * 4 + g) * 16384;
    for (int e = tid; e < 16384; e += 512) pwl[e] = pwg[e];
    __syncthreads();
    const float* w = P.in[I_OWIN] + (size_t)i * 1024 * 3072 + g * 128;
    const int d = tid & 127, kg = tid >> 7, kbase = ks * 128 + kg * 32;
    const float sc = P.in[I_POOLS][(size_t)i * 512 + g * 128 + d];
    h16* dst = WSP(h16, WS_WOIN + (size_t)i * SZ_WOIN) + (size_t)(g * 128 + d) * 1024 + kbase;
    for (int kq = 0; kq < 32; kq += 8) {
        float o[8];
#pragma unroll
        for (int q = 0; q < 8; ++q) o[q] = 0.f;
        for (int c = 0; c < 128; ++c) { const float mv = pwl[c * 128 + d];
#pragma unroll
            for (int q = 0; q < 8; ++q) o[q] += w[(size_t)(kbase + kq + q) * 3072 + c] * mv; }
        u32x4 a; a.x = pkh(o[0] * sc, o[1] * sc); a.y = pkh(o[2] * sc, o[3] * sc); a.z = pkh(o[4] * sc, o[5] * sc); a.w = pkh(o[6] * sc, o[7] * sc);
        *(u32x4*)(dst + kq) = a;
    }
    __syncthreads();
}
__device__ __forceinline__ void p0_ada_item(Frame& F, int item) {
    const Params& P = *F.p;
    const int l = item / 48, n0 = (item % 48) * 64, tid = F.tid, w = F.wave, lane = F.lane;
    LAS float* sc = (LAS float*)F.lds;
    LAS float* red = (LAS float*)(F.lds + 36864);
    for (int e = tid; e < 9 * 1024; e += 512) { const int r = e >> 10, k = e & 1023; const float v = (r < 8) ? P.in[I_C][r * 1024 + k] : P.in[I_CCTX][k]; sc[e] = siluf_(v); }
    __syncthreads();
    const int kq = lane >> 4, nq = lane & 15;
    const float* wp = P.in[I_ADAW] + (size_t)l * 1024 * 3072 + n0 + 4 * nq;
    f32x4 acc[9];
#pragma unroll
    for (int r = 0; r < 9; ++r) acc[r] = (f32x4){0.f, 0.f, 0.f, 0.f};
#pragma unroll 8
    for (int it = 0; it < 32; ++it) { const int k = w * 128 + it * 4 + kq; const f32x4 wv = *(const f32x4*)(wp + (size_t)k * 3072);
#pragma unroll
        for (int r = 0; r < 9; ++r) acc[r] += wv * sc[r * 1024 + k]; }
#pragma unroll
    for (int r = 0; r < 9; ++r)
#pragma unroll
        for (int j = 0; j < 4; ++j) { float v = acc[r][j]; v += SWZ_XOR(v, 16); v += xor32(v, lane); acc[r][j] = v; }
    if (kq == 0) {
#pragma unroll
        for (int r = 0; r < 9; ++r)
#pragma unroll
            for (int j = 0; j < 4; ++j) red[(w * 16 + nq) * 36 + r * 4 + j] = acc[r][j]; }
    __syncthreads();
    for (int e = tid; e < 576; e += 512) { const int r = e / 64, col = e % 64, q = col >> 2, j = col & 3; float s = 0.f;
#pragma unroll
        for (int ww = 0; ww < 8; ++ww) s += red[(ww * 16 + q) * 36 + r * 4 + j];
        WSP(float, WS_ADA)[((size_t)l * 9 + r) * 3072 + n0 + col] = s + P.in[I_ADAB][(size_t)l * 3072 + n0 + col]; }
    __syncthreads();
}
__device__ __forceinline__ void p0_prologue(Frame& F) {
    const Params& P = *F.p;
    for (int it = F.vcu; it < 488; it += F.G) {
        if (it < 96) p0_s5_item(F, it / 48, it % 48);
        else if (it < 224) p0_fnet_item(F, it - 96);
        else if (it < 288) p0_pool_item(F, it - 224);
        else if (it < 480) p0_ada_item(F, it - 288);
        else { const int q = it - 480;
            for (int e = q * 512 + F.tid; e < 256 * 512; e += 8 * 512) { const int k2 = e >> 9, c = e & 511, t2 = c & 255; float s, co; sincospif((float)((k2 * t2) & 255) * (1.0f / 128.0f), &s, &co);
                WSP(h16, WS_WB)[e] = (h16)(c < 256 ? co : s); }
            for (int e = q * 512 + F.tid; e < 96 * 512; e += 8 * 512) { const int r = e >> 9, qq = e & 511, k = qq & 255; const float rr = (float)(r < 32 ? r : r - 32);
                const float om = expf(-(float)k * (9.210340371976184f / 256.0f));
                const double rev = (double)rr * (double)om * 0.15915494309189535; const double fr = rev - __builtin_rint(rev);
                float s, co; sincospif((float)(2.0 * fr), &s, &co);
                WSP(float, WS_POS)[e] = (qq < 256) ? s : co; }
        }
    }
    LAS float* scr = (LAS float*)(F.lds + F.wave * 16384);
    const int gw = F.vcu * 8 + F.wave, NGW = F.G * 8;
    constexpr int I_EIN = 16 * 56, I_GLU = 12 * 24, I_EO = 16 * 32, I_OIN = 16 * 80, I_OO = 16 * 32, I_LAYER = I_EIN + I_GLU + I_EO + I_OIN + I_OO;
    for (int it = gw; it < 2 * I_LAYER; it += NGW) {
        const int i = it / I_LAYER; int r = it % I_LAYER;
        if (r < I_EIN) { const int kb = r / 56, nb = r % 56;
            const int n_src0 = (nb < 24) ? 0 : 256;
            p0_transpose_item(P.in[I_EWIN] + (size_t)i * 1024 * 2048, 1024, 2048, n_src0, 56, WSP(h16, WS_WEIN + (size_t)i * SZ_WEIN), 0, scr, kb * 56 + nb, F.lane); continue; } r -= I_EIN;
        if (r < I_GLU) { p0_transpose_item(P.in[I_GLUW] + (size_t)i * 768 * 768, 768, 768, 0, 24, WSP(h16, WS_WGLU + (size_t)i * SZ_WGLU), 0, scr, r, F.lane); continue; } r -= I_GLU;
        if (r < I_EO) { p0_transpose_item(P.in[I_EWOUT] + (size_t)i * 1024 * 1024, 1024, 1024, 0, 32, WSP(h16, WS_WEOUT + (size_t)i * SZ_WOUT), 0, scr, r, F.lane); continue; } r -= I_EO;
        if (r < I_OIN) { p0_transpose_item(P.in[I_OWIN] + (size_t)i * 1024 * 3072, 1024, 3072, 512, 80, WSP(h16, WS_WOIN + (size_t)i * SZ_WOIN), 512, scr, r, F.lane); continue; } r -= I_OIN;
        p0_transpose_item(P.in[I_OWOUT] + (size_t)i * 1024 * 1024, 1024, 1024, 0, 32, WSP(h16, WS_WOOUT + (size_t)i * SZ_WOUT), 0, scr, r, F.lane);
    }
}

__device__ __forceinline__ void norm_phase(Frame& F, int l, bool with_ctx) {
    const Params& P = *F.p;
    const int gw = F.vcu * 8 + F.wave, NGW = F.G * 8, lane = F.lane;
    const int nrows = with_ctx ? NTOK : NLAT;
    const float* ng = P.in[I_NORMG] + (size_t)l * 1024;
    const float* ada = WSP(float, WS_ADA) + (size_t)l * 9 * 3072;
    h16* H = WSP(h16, WS_H);
    for (int r = gw; r < nrows; r += NGW) {
        const bool lat = r < NLAT; const int br = lat ? (r >> 11) : 8;
        f32x4 v[4];
        if (l == 0) {
            if (lat) { const int t = r & 2047; const f32x4* xr = (const f32x4*)(P.in[I_X] + (size_t)r * 1024) + lane;
                const f32x4* rt = (const f32x4*)(WSP(float, WS_POS) + (size_t)(t >> 6) * 512) + lane; const f32x4* ct = (const f32x4*)(WSP(float, WS_POS) + (size_t)(32 + (t & 63)) * 512) + lane;
                v[0] = xr[0] + rt[0]; v[1] = xr[64] + rt[64]; v[2] = xr[128] + ct[0]; v[3] = xr[192] + ct[64];
                f32x4* xo = (f32x4*)(P.out + (size_t)r * 1024) + lane;
#pragma unroll
                for (int j = 0; j < 4; ++j) xo[64 * j] = v[j];
            } else { const f32x4* xr = (const f32x4*)(P.in[I_CTX] + (size_t)(r - NLAT) * 1024) + lane; f32x4* xo = (f32x4*)(WSP(float, WS_XC) + (size_t)(r - NLAT) * 1024) + lane;
#pragma unroll
                for (int j = 0; j < 4; ++j) { v[j] = xr[64 * j]; xo[64 * j] = v[j]; } }
        } else { const f32x4* xr = (lat ? (const f32x4*)(P.out + (size_t)r * 1024) : (const f32x4*)(WSP(float, WS_XC) + (size_t)(r - NLAT) * 1024)) + lane;
#pragma unroll
            for (int j = 0; j < 4; ++j) v[j] = xr[64 * j]; }
        float s = 0.f;
#pragma unroll
        for (int j = 0; j < 4; ++j) s += (v[j].x * v[j].x + v[j].y * v[j].y) + (v[j].z * v[j].z + v[j].w * v[j].w);
        const float rstd = 1.0f / sqrtf(wave_sum(s, lane) * (1.0f / 1024.0f) + 1e-6f);
        const f32x4* g4 = (const f32x4*)ng + lane; const f32x4* sh4 = (const f32x4*)(ada + (size_t)br * 3072) + lane; const f32x4* sc4 = (const f32x4*)(ada + (size_t)br * 3072 + 1024) + lane;
        u32x2* o8 = (u32x2*)(H + (size_t)r * 1024) + lane;
#pragma unroll
        for (int j = 0; j < 4; ++j) { const f32x4 y = v[j] * rstd * g4[64 * j] * (sc4[64 * j] + 1.0f) + sh4[64 * j]; u32x2 o; o.x = pkh(y.x, y.y); o.y = pkh(y.z, y.w); o8[64 * j] = o; }
    }
}
__device__ __forceinline__ void final_norm_phase(Frame& F) {
    const Params& P = *F.p;
    const int gw = F.vcu * 8 + F.wave, NGW = F.G * 8, lane = F.lane;
    const f32x4* g4 = (const f32x4*)P.in[I_FINALG] + lane;
    for (int r = gw; r < NLAT; r += NGW) {
        f32x4* xr = (f32x4*)(P.out + (size_t)r * 1024) + lane; f32x4 v[4]; float s = 0.f;
#pragma unroll
        for (int j = 0; j < 4; ++j) { v[j] = xr[64 * j]; s += (v[j].x * v[j].x + v[j].y * v[j].y) + (v[j].z * v[j].z + v[j].w * v[j].w); }
        const float rstd = 1.0f / sqrtf(wave_sum(s, lane) * (1.0f / 1024.0f) + 1e-6f);
#pragma unroll
        for (int j = 0; j < 4; ++j) xr[64 * j] = v[j] * rstd * g4[64 * j];
    }
}

struct Sched3 {
    const char* A0; const char* B0; int nM0, nN0;
    const char* A1; const char* B1; int nM1, nN1;
    const char* A2; const char* B2; int nM2, nN2;
    int G, c, lda, ldb;
    __device__ __forceinline__ bool next(int i, Unit& u) const {
        int L = i * G + c; int pm, pn;
        const int n0 = nM0 * nN0, n1 = nM1 * nN1, n2 = nM2 * nN2;
        if (L < n0) { pg8::tile_of(pg8::xcd_remap(L, n0), nM0, nN0, pm, pn); u.job = 0; u.pm = pm; u.pn = pn; u.aux = 0; u.a = A0 + (size_t)pm * 512 * lda; u.b = B0 + (size_t)pn * 512 * ldb; return true; }
        L -= n0;
        if (L < n1) { pg8::tile_of(pg8::xcd_remap(L, n1), nM1, nN1, pm, pn); u.job = 1; u.pm = pm; u.pn = pn; u.aux = 0; u.a = A1 + (size_t)pm * 512 * lda; u.b = B1 + (size_t)pn * 512 * ldb; return true; }
        L -= n1;
        if (L < n2) { pg8::tile_of(pg8::xcd_remap(L, n2), nM2, nN2, pm, pn); u.job = 2; u.pm = pm; u.pn = pn; u.aux = 0; u.a = A2 + (size_t)pm * 512 * lda; u.b = B2 + (size_t)pn * 512 * ldb; return true; }
        return false;
    }
};
struct SchedS5 {
    const char* UA; const char* W; size_t wstride; int nMt, G, c;
    __device__ __forceinline__ bool next(int i, Unit& u) const {
        const int L = i * G + c, n = NGRP * nMt; if (L >= n) return false;
        const int w = pg8::xcd_remap(L, n), g = w / nMt, pm = w % nMt;
        u.job = 0; u.pm = pm; u.pn = 0; u.aux = g; u.a = UA + ((size_t)g * UA_ROWS + (size_t)pm * 256) * UA_LD * 2; u.b = W + (size_t)g * wstride; return true;
    }
};

#define EPI_ROWS_BEGIN  _Pragma("unroll") for (int ai = 0; ai < 2; ++ai) _Pragma("unroll") for (int m = 0; m < 4; ++m) { const int rl = ai * 128 + wr * 64 + m * 16;
#define EPI_ROWS_END    asm volatile("" ::: "memory"); }

struct EpiEvenIn {
    h16* UA; h16* SZ; h16* ZT; h16* YB;
    __device__ __forceinline__ void operator()(const Acc& acc, const Unit& u, int wr, int wc, int fr, int fq) const {
        if (u.job < 2) {
            const int tile = (u.job == 0) ? u.pm : 64 + u.pm;
            EPI_ROWS_BEGIN
                const int r16 = tile * 256 + rl;
                int crow; if (u.job == 0) crow = (r16 >> 11) * 128 + ((r16 & 2047) >> 4); else { const int rc = r16 - NLAT; crow = 1024 + (rc >> 8) * 16 + ((rc & 255) >> 4); }
#pragma unroll
                for (int bj = 0; bj < 2; ++bj) { const int c0 = u.pn * 256 + bj * 128 + wc * 32 + 8 * fq; const f32x4 v0 = acc[ai][bj][m][0], v1 = acc[ai][bj][m][1]; u32x4 w;
                    if (u.pn < 3) { w.x = pkh(v0[0], v0[1]); w.y = pkh(v0[2], v0[3]); w.z = pkh(v1[0], v1[1]); w.w = pkh(v1[2], v1[3]);
                        const int g = c0 >> 4, h0 = c0 & 15;
                        *(u32x4*)(UA + ((size_t)g * UA_ROWS + crow) * UA_LD + fr * 16 + h0) = w;
                    } else { w.x = pkh(siluf_(v0[0]), siluf_(v0[1])); w.y = pkh(siluf_(v0[2]), siluf_(v0[3])); w.z = pkh(siluf_(v1[0]), siluf_(v1[1])); w.w = pkh(siluf_(v1[2]), siluf_(v1[3]));
                        *(u32x4*)(SZ + (size_t)(r16 + fr) * 1024 + (c0 - 768)) = w; } }
            EPI_ROWS_END
        } else {
            EPI_ROWS_BEGIN
                const int ch = rl + fr;
#pragma unroll
                for (int bj = 0; bj < 2; ++bj) { const int cl = bj * 128 + wc * 32 + 8 * fq; f32x4 v0 = acc[ai][bj][m][0], v1 = acc[ai][bj][m][1]; u32x4 w;
                    if (u.pn < 64) { w.x = pkh(v0[0], v0[1]); w.y = pkh(v0[2], v0[3]); w.z = pkh(v1[0], v1[1]); w.w = pkh(v1[2], v1[3]);
                        *(u32x4*)(ZT + (size_t)(u.pm * 256 + ch) * NLAT + u.pn * 256 + cl) = w;
                    } else { if (u.pm) { v0 = -v0; v1 = -v1; } w.x = pkh(v0[0], v0[1]); w.y = pkh(v0[2], v0[3]); w.z = pkh(v1[0], v1[1]); w.w = pkh(v1[2], v1[3]);
                        *(u32x4*)(YB + (size_t)(NLAT + (u.pn - 64) * 256 + ch) * 512 + u.pm * 256 + cl) = w; } }
            EPI_ROWS_END
        }
    }
};
struct EpiS5E {
    h16* UA;
    __device__ __forceinline__ void operator()(const Acc& acc, const Unit& u, int wr, int wc, int fr, int fq) const {
        EPI_ROWS_BEGIN
            const int row = u.pm * 256 + rl + fr;
#pragma unroll
            for (int bj = 0; bj < 2; ++bj) { const int c0 = bj * 128 + wc * 32 + 8 * fq; const f32x4 v0 = acc[ai][bj][m][0], v1 = acc[ai][bj][m][1]; u32x4 w;
                w.x = pkh(v0[0], v0[1]); w.y = pkh(v0[2], v0[3]); w.z = pkh(v1[0], v1[1]); w.w = pkh(v1[2], v1[3]);
                *(u32x4*)(UA + ((size_t)u.aux * UA_ROWS + row) * UA_LD + 256 + c0) = w; }
        EPI_ROWS_END
    }
};
struct EpiS5Y {
    h16* YA;
    __device__ __forceinline__ void operator()(const Acc& acc, const Unit& u, int wr, int wc, int fr, int fq) const {
        EPI_ROWS_BEGIN
            const int row = u.pm * 256 + rl + fr;
            int tok0; bool ok = true;
            if (row < 1024) tok0 = (row >> 7) * 2048 + (row & 127) * 16; else if (row < 1152) { const int rc = row - 1024; tok0 = NLAT + (rc >> 4) * 256 + (rc & 15) * 16; } else { tok0 = 0; ok = false; }
            if (ok) {
#pragma unroll
                for (int bj = 0; bj < 2; ++bj) { const int c0 = bj * 128 + wc * 32 + 8 * fq, k = c0 >> 4, h0 = c0 & 15; const f32x4 v0 = acc[ai][bj][m][0] * (1.0f / SIG2), v1 = acc[ai][bj][m][1] * (1.0f / SIG2); u32x4 w;
                    w.x = pkh(gelu_tanh_(v0[0]), gelu_tanh_(v0[1])); w.y = pkh(gelu_tanh_(v0[2]), gelu_tanh_(v0[3])); w.z = pkh(gelu_tanh_(v1[0]), gelu_tanh_(v1[1])); w.w = pkh(gelu_tanh_(v1[2]), gelu_tanh_(v1[3]));
                    *(u32x4*)(YA + (size_t)(tok0 + k) * 768 + u.aux * 16 + h0) = w; } }
        EPI_ROWS_END
    }
};
struct EpiFnetB {
    h16* Y; const h16* SZ;
    __device__ __forceinline__ void operator()(const Acc& acc, const Unit& u, int wr, int wc, int fr, int fq) const {
        const bool lat = u.pn < 64; const float nrm = lat ? 0.0027621358640099515f : 0.0078125f;
        EPI_ROWS_BEGIN
            const int k2 = rl + fr;
            const int tok = lat ? ((u.pn >> 3) * 2048 + (u.pn & 7) + 8 * k2) : (NLAT + (u.pn - 64) * 256 + k2);
#pragma unroll
            for (int bj = 0; bj < 2; ++bj) { const int ch = bj * 128 + wc * 32 + 8 * fq; const f32x4 v0 = acc[ai][bj][m][0] * nrm, v1 = acc[ai][bj][m][1] * nrm;
                const size_t off = (size_t)tok * 1024 + 768 + ch; const u32x4 z = *(const u32x4*)(SZ + off); u32x4 w;
                const f32x2 z0 = unpkh(z.x), z1 = unpkh(z.y), z2 = unpkh(z.z), z3 = unpkh(z.w);
                w.x = pkh(v0[0] * z0.x, v0[1] * z0.y); w.y = pkh(v0[2] * z1.x, v0[3] * z1.y); w.z = pkh(v1[0] * z2.x, v1[1] * z2.y); w.w = pkh(v1[2] * z3.x, v1[3] * z3.y);
                *(u32x4*)(Y + off) = w; }
        EPI_ROWS_END
    }
};
struct EpiGlu {
    h16* Y; const h16* YA; const h16* SZ; const float* bias;
    __device__ __forceinline__ void operator()(const Acc& acc, const Unit& u, int wr, int wc, int fr, int fq) const {
        const int tile = (u.job == 0) ? u.pm : 64 + u.pm;
        f32x4 bv[2][2];
#pragma unroll
        for (int bj = 0; bj < 2; ++bj)
#pragma unroll
            for (int n = 0; n < 2; ++n) bv[bj][n] = *(const f32x4*)(bias + u.pn * 256 + bj * 128 + wc * 32 + 8 * fq + 4 * n);
        EPI_ROWS_BEGIN
            const size_t r = (size_t)tile * 256 + rl + fr;
#pragma unroll
            for (int bj = 0; bj < 2; ++bj) { const int c0 = u.pn * 256 + bj * 128 + wc * 32 + 8 * fq; const f32x4 v0 = acc[ai][bj][m][0] + bv[bj][0], v1 = acc[ai][bj][m][1] + bv[bj][1];
                const u32x4 a = *(const u32x4*)(YA + r * 768 + c0), z = *(const u32x4*)(SZ + r * 1024 + c0); u32x4 w;
                const f32x2 a0 = unpkh(a.x), a1 = unpkh(a.y), a2 = unpkh(a.z), a3 = unpkh(a.w), z0 = unpkh(z.x), z1 = unpkh(z.y), z2 = unpkh(z.z), z3 = unpkh(z.w);
                w.x = pkh(a0.x * sigmoidf_(v0[0]) * z0.x, a0.y * sigmoidf_(v0[1]) * z0.y); w.y = pkh(a1.x * sigmoidf_(v0[2]) * z1.x, a1.y * sigmoidf_(v0[3]) * z1.y);
                w.z = pkh(a2.x * sigmoidf_(v1[0]) * z2.x, a2.y * sigmoidf_(v1[1]) * z2.y); w.w = pkh(a3.x * sigmoidf_(v1[2]) * z3.x, a3.y * sigmoidf_(v1[3]) * z3.y);
                *(u32x4*)(Y + r * 1024 + c0) = w; }
        EPI_ROWS_END
    }
};
struct EpiOut {
    float* XL; float* XC; const float* ada;
    __device__ __forceinline__ void operator()(const Acc& acc, const Unit& u, int wr, int wc, int fr, int fq) const {
        const int br = (u.job == 0) ? (u.pm >> 3) : 8;
        float* X = (u.job == 0) ? XL : XC;
        f32x4 gv[2][2];
#pragma unroll
        for (int bj = 0; bj < 2; ++bj)
#pragma unroll
            for (int n = 0; n < 2; ++n) gv[bj][n] = *(const f32x4*)(ada + (size_t)br * 3072 + 2048 + u.pn * 256 + bj * 128 + wc * 32 + 8 * fq + 4 * n);
        EPI_ROWS_BEGIN
            float* rowp = X + ((size_t)u.pm * 256 + rl + fr) * 1024 + u.pn * 256 + wc * 32 + 8 * fq;
#pragma unroll
            for (int bj = 0; bj < 2; ++bj)
#pragma unroll
                for (int n = 0; n < 2; ++n) { f32x4* p = (f32x4*)(rowp + bj * 128 + 4 * n); *p = *p + gv[bj][n] * acc[ai][bj][m][n]; }
        EPI_ROWS_END
    }
};
struct EpiOddIn {
    h16* Pb; h16* SZ;
    __device__ __forceinline__ void operator()(const Acc& acc, const Unit& u, int wr, int wc, int fr, int fq) const {
        const int tile = (u.job == 0) ? u.pm : 64 + u.pm;
        EPI_ROWS_BEGIN
            const size_t r = (size_t)tile * 256 + rl + fr;
#pragma unroll
            for (int bj = 0; bj < 2; ++bj) { const int c0 = u.pn * 256 + bj * 128 + wc * 32 + 8 * fq; const f32x4 v0 = acc[ai][bj][m][0], v1 = acc[ai][bj][m][1]; u32x4 w;
                if (u.pn < 8) { w.x = pkh(v0[0], v0[1]); w.y = pkh(v0[2], v0[3]); w.z = pkh(v1[0], v1[1]); w.w = pkh(v1[2], v1[3]); *(u32x4*)(Pb + r * 2048 + c0) = w; }
                else { w.x = pkh(siluf_(v0[0]), siluf_(v0[1])); w.y = pkh(siluf_(v0[2]), siluf_(v0[3])); w.z = pkh(siluf_(v1[0]), siluf_(v1[1])); w.w = pkh(siluf_(v1[2]), siluf_(v1[3]));
                    *(u32x4*)(SZ + r * 1024 + (c0 - 2048)) = w; } }
        EPI_ROWS_END
    }
};

__device__ __forceinline__ void fnet_stage_a(Frame& F) {
    const h16* ZT = WSP(h16, WS_ZT); h16* YB = WSP(h16, WS_YB);
    constexpr float RS = 0.70710678118654752f;
    const float c8[8] = {1.f, RS, 0.f, -RS, -1.f, -RS, 0.f, RS}, s8[8] = {0.f, RS, 1.f, RS, 0.f, -RS, -1.f, -RS};
    for (int it = F.vcu; it < 512; it += F.G) {
        const int e = it * 512 + F.tid, tp = e & 127, ch = (e >> 7) & 255, b = e >> 15, t2 = tp * 2;
        float zr[8][2], zi[8][2];
#pragma unroll
        for (int t1 = 0; t1 < 8; ++t1) { const size_t o = (size_t)b * 2048 + 256 * t1 + t2;
            const f32x2 a = unpkh(*(const unsigned*)(ZT + (size_t)ch * NLAT + o)), s = unpkh(*(const unsigned*)(ZT + (size_t)(256 + ch) * NLAT + o));
            zr[t1][0] = a.x; zr[t1][1] = a.y; zi[t1][0] = -s.x; zi[t1][1] = -s.y; }
#pragma unroll
        for (int k1 = 0; k1 < 8; ++k1) {
            float yr[2] = {0.f, 0.f}, yi[2] = {0.f, 0.f};
#pragma unroll
            for (int t1 = 0; t1 < 8; ++t1) { const float cw = c8[(k1 * t1) & 7], sw = s8[(k1 * t1) & 7];
#pragma unroll
                for (int q = 0; q < 2; ++q) { yr[q] += zr[t1][q] * cw + zi[t1][q] * sw; yi[q] += zi[t1][q] * cw - zr[t1][q] * sw; } }
            float o_re[2], o_im[2];
#pragma unroll
            for (int q = 0; q < 2; ++q) { float sn, cs; sincospif((float)(k1 * (t2 + q)) * (1.0f / 1024.0f), &sn, &cs);
                o_re[q] = yr[q] * cs + yi[q] * sn; o_im[q] = yi[q] * cs - yr[q] * sn; }
            h16* dst = YB + (size_t)((b * 8 + k1) * 256 + ch) * 512 + t2;
            *(unsigned*)dst = pkh(o_re[0], o_re[1]); *(unsigned*)(dst + 256) = pkh(o_im[0], o_im[1]);
        }
    }
}
__device__ __forceinline__ void s5_scan(Frame& F, int i, int first_block) {
    int vb = F.bx - first_block; if (vb < 0) vb += F.G;
    for (int it = vb; it < 96; it += F.G) {
        const int tid = F.tid, p = tid & 63, dir = (tid >> 6) & 1, pr = it * 4 + (tid >> 7), b = pr / NGRP, g = pr % NGRP;
        const f32x2 lw = WSP(f32x2, WS_LAM)[(((size_t)i * 2 + dir) * NGRP + g) * 64 + p];
        h16* base = WSP(h16, WS_UA) + (size_t)g * UA_ROWS * UA_LD + 256 + dir * 128 + 2 * p;
        float sr = 0.f, si = 0.f;
#pragma unroll 1
        for (int seg = 0; seg < 2; ++seg) {
            const int nc = seg == 0 ? 16 : 128; h16* rb = base + (size_t)(seg == 0 ? 1024 + b * 16 : b * 128) * UA_LD;
#pragma unroll 1
            for (int c0 = 0; c0 < nc; c0 += 16) {
                unsigned ev[16];
#pragma unroll
                for (int q = 0; q < 16; ++q) { const int c = dir == 0 ? c0 + q : nc - 1 - (c0 + q); ev[q] = *(const unsigned*)(rb + (size_t)c * UA_LD); }
#pragma unroll
                for (int q = 0; q < 16; ++q) { const int c = dir == 0 ? c0 + q : nc - 1 - (c0 + q); const f32x2 e = unpkh(ev[q]);
                    *(unsigned*)(rb + (size_t)c * UA_LD) = pkh(sr, si);
                    const float nr = lw.x * sr - lw.y * si + e.x, ni = lw.x * si + lw.y * sr + e.y; sr = nr; si = ni; }
            }
        }
    }
}
__device__ __forceinline__ void conv_ldv(const h16* Pb, int r, int s0, int s1, int c8, float (&v)[8]) {
    if (r >= s0 && r < s1) { const u32x4 a = *(const u32x4*)(Pb + (size_t)r * 2048 + 512 + c8), b = *(const u32x4*)(Pb + (size_t)r * 2048 + 1024 + c8);
        const f32x2 a0 = unpkh(a.x), a1 = unpkh(a.y), a2 = unpkh(a.z), a3 = unpkh(a.w), b0 = unpkh(b.x), b1 = unpkh(b.y), b2 = unpkh(b.z), b3 = unpkh(b.w);
        v[0] = a0.x * b0.x; v[1] = a0.y * b0.y; v[2] = a1.x * b1.x; v[3] = a1.y * b1.y; v[4] = a2.x * b2.x; v[5] = a2.y * b2.y; v[6] = a3.x * b3.x; v[7] = a3.y * b3.y;
    } else {
#pragma unroll
        for (int q = 0; q < 8; ++q) v[q] = 0.f; }
}
__device__ __forceinline__ void odd_mix_phase(Frame& F, int i, bool with_ctx) {
    const Params& Pm = *F.p;
    const h16* Pb = WSP(h16, WS_P); const h16* SZ = WSP(h16, WS_SZ); h16* Y = WSP(h16, WS_H);
    const float* cw = Pm.in[I_CONVW] + (size_t)i * 3 * 512;
    const int nrows = with_ctx ? NTOK : NLAT, nseg = nrows / 16;
    const int gw = F.vcu * 8 + F.wave, NGW = F.G * 8, lane = F.lane;
    for (int it = gw; it < nseg * 2; it += NGW) {
        const int seg = it >> 1, kind = it & 1, r0 = seg * 16;
        const bool lat = r0 < NLAT; const int s0 = lat ? (r0 & ~2047) : (NLAT + ((r0 - NLAT) & ~255)), s1 = s0 + (lat ? 2048 : 256);
        const int c8 = lane * 8;
        if (kind == 0) {
            const int hw = 1 << (lane >> 4);
            float sum[8];
#pragma unroll
            for (int q = 0; q < 8; ++q) sum[q] = 0.f;
            for (int r = r0 - hw; r < r0 + hw; ++r) if (r >= s0 && r < s1) { const u32x4 v = *(const u32x4*)(Pb + (size_t)r * 2048 + c8);
                const f32x2 a = unpkh(v.x), b = unpkh(v.y), c = unpkh(v.z), d = unpkh(v.w); sum[0] += a.x; sum[1] += a.y; sum[2] += b.x; sum[3] += b.y; sum[4] += c.x; sum[5] += c.y; sum[6] += d.x; sum[7] += d.y; }
            for (int r = r0; r < r0 + 16; ++r) {
                const int lo = max(r - hw, s0), hi = min(r + hw, s1); const float inv = 1.0f / (float)(hi - lo);
                const u32x4 sv = *(const u32x4*)(Pb + (size_t)r * 2048 + c8), zv = *(const u32x4*)(SZ + (size_t)r * 1024 + c8);
                float me[8], z[8]; { const f32x2 a = unpkh(sv.x), b = unpkh(sv.y), c = unpkh(sv.z), d = unpkh(sv.w); me[0] = a.x; me[1] = a.y; me[2] = b.x; me[3] = b.y; me[4] = c.x; me[5] = c.y; me[6] = d.x; me[7] = d.y; }
                { const f32x2 a = unpkh(zv.x), b = unpkh(zv.y), c = unpkh(zv.z), d = unpkh(zv.w); z[0] = a.x; z[1] = a.y; z[2] = b.x; z[3] = b.y; z[4] = c.x; z[5] = c.y; z[6] = d.x; z[7] = d.y; }
                float o[8];
#pragma unroll
                for (int q = 0; q < 8; ++q) o[q] = (sum[q] * inv - me[q]) * z[q];
                u32x4 w; w.x = pkh(o[0], o[1]); w.y = pkh(o[2], o[3]); w.z = pkh(o[4], o[5]); w.w = pkh(o[6], o[7]);
                *(u32x4*)(Y + (size_t)r * 1024 + c8) = w;
                const int ra = r + hw, rd = r - hw;
                if (ra < s1) { const u32x4 v = *(const u32x4*)(Pb + (size_t)ra * 2048 + c8); const f32x2 a = unpkh(v.x), b = unpkh(v.y), c = unpkh(v.z), d = unpkh(v.w);
                    sum[0] += a.x; sum[1] += a.y; sum[2] += b.x; sum[3] += b.y; sum[4] += c.x; sum[5] += c.y; sum[6] += d.x; sum[7] += d.y; }
                if (rd >= s0) { const u32x4 v = *(const u32x4*)(Pb + (size_t)rd * 2048 + c8); const f32x2 a = unpkh(v.x), b = unpkh(v.y), c = unpkh(v.z), d = unpkh(v.w);
                    sum[0] -= a.x; sum[1] -= a.y; sum[2] -= b.x; sum[3] -= b.y; sum[4] -= c.x; sum[5] -= c.y; sum[6] -= d.x; sum[7] -= d.y; }
            }
        } else {
            float w0[8], w1[8], w2[8];
#pragma unroll
            for (int q = 0; q < 8; ++q) { w0[q] = cw[c8 + q]; w1[q] = cw[512 + c8 + q]; w2[q] = cw[1024 + c8 + q]; }
            float vm[8], vc[8], vp[8];
            conv_ldv(Pb, r0 - 1, s0, s1, c8, vm); conv_ldv(Pb, r0, s0, s1, c8, vc);
            for (int r = r0; r < r0 + 16; ++r) {
                conv_ldv(Pb, r + 1, s0, s1, c8, vp);
                const u32x4 gv = *(const u32x4*)(Pb + (size_t)r * 2048 + 1536 + c8), zv = *(const u32x4*)(SZ + (size_t)r * 1024 + 512 + c8);
                float gg[8], z[8]; { const f32x2 a = unpkh(gv.x), b = unpkh(gv.y), c = unpkh(gv.z), d = unpkh(gv.w); gg[0] = a.x; gg[1] = a.y; gg[2] = b.x; gg[3] = b.y; gg[4] = c.x; gg[5] = c.y; gg[6] = d.x; gg[7] = d.y; }
                { const f32x2 a = unpkh(zv.x), b = unpkh(zv.y), c = unpkh(zv.z), d = unpkh(zv.w); z[0] = a.x; z[1] = a.y; z[2] = b.x; z[3] = b.y; z[4] = c.x; z[5] = c.y; z[6] = d.x; z[7] = d.y; }
                float o[8];
#pragma unroll
                for (int q = 0; q < 8; ++q) { o[q] = gg[q] * (vm[q] * w0[q] + vc[q] * w1[q] + vp[q] * w2[q]) * z[q]; vm[q] = vc[q]; vc[q] = vp[q]; }
                u32x4 w; w.x = pkh(o[0], o[1]); w.y = pkh(o[2], o[3]); w.z = pkh(o[4], o[5]); w.w = pkh(o[6], o[7]);
                *(u32x4*)(Y + (size_t)r * 1024 + 512 + c8) = w;
            }
        }
    }
}

enum { PT_PROLOGUE = 0, PT_NORM, PT_EIN, PT_S5E, PT_SCAN, PT_S5Y, PT_GLU, PT_OUT, PT_OIN, PT_OMIX, PT_FINAL };
__device__ __forceinline__ void decode_phase(int ph, int& type, int& l) {
    if (ph == 0) { type = PT_PROLOGUE; l = 0; return; }
    if (ph == N_PHASES - 1) { type = PT_FINAL; l = 3; return; }
    int q = ph - 1;
    if (q < 7) { l = 0; type = PT_NORM + q; return; } q -= 7;
    if (q < 4) { l = 1; type = (q == 0) ? PT_NORM : (q == 1) ? PT_OIN : (q == 2) ? PT_OMIX : PT_OUT; return; } q -= 4;
    if (q < 7) { l = 2; type = PT_NORM + q; return; } q -= 7;
    l = 3; type = (q == 0) ? PT_NORM : (q == 1) ? PT_OIN : (q == 2) ? PT_OMIX : PT_OUT;
}

__global__ void __launch_bounds__(512, 2) fwd_kernel(Params prm) {
    extern __shared__ __attribute__((aligned(16))) unsigned char lds_raw[];
    Frame F;
    F.lds = (LAS unsigned char*)lds_raw;
    F.tid = threadIdx.x; F.lane = F.tid & 63; F.wave = __builtin_amdgcn_readfirstlane(F.tid >> 6);
    F.G = gridDim.x; F.bx = blockIdx.x; { const int bx = blockIdx.x; F.vcu = (F.G % 8 == 0) ? (bx % 8) * (F.G / 8) + bx / 8 : bx; }
    F.p = &prm; F.ws = prm.ws;
    volatile LAS unsigned* MISC = (volatile LAS unsigned*)(F.lds + MISC_OFF);
    if (F.tid < 64) MISC[F.tid] = 0u;
    __syncthreads();
    XcdBarrier bar; bar.bar = (unsigned*)(F.ws + WS_CTL) + 4096; bar.x = 0; bar.st = nullptr;
    if (prm.ph_hi - prm.ph_lo > 1) bar = xcd_barrier_post((unsigned*)(F.ws + WS_CTL) + 4096, MISC + 8, F.tid == 0);

    const int wave_s = F.wave;
    for (int ph_ = prm.ph_lo; ph_ < prm.ph_hi; ++ph_) {
        const int ph = __builtin_amdgcn_readfirstlane(ph_);
        int type, l; decode_phase(ph, type, l);
        const int i = l >> 1;
        {
            int wv_ = wave_s; asm volatile("" : "+s"(wv_));
            int tid_ = wv_ * 64 + (int)__builtin_amdgcn_mbcnt_hi(~0u, __builtin_amdgcn_mbcnt_lo(~0u, 0u)); asm volatile("" : "+v"(tid_)); F.tid = tid_; F.lane = tid_ & 63; F.wave = wv_;
            unsigned zero_ = 0u; asm volatile("" : "+s"(zero_));
            int bx_ = blockIdx.x; asm volatile("" : "+s"(bx_)); F.bx = bx_; F.G = gridDim.x; F.vcu = (F.G % 8 == 0) ? (bx_ % 8) * (F.G / 8) + bx_ / 8 : bx_;
            F.ws = prm.ws + zero_; F.p = (const Params*)((const char*)&prm + zero_);
        }
        const bool need_ctx = (l < 2);
        const bool ctx_in = (l < 3);
#ifndef PH_MASK
#define PH_MASK 0xFFFF
#endif
        if (!((PH_MASK >> type) & 1)) continue;
        switch (type) {
        case PT_PROLOGUE: p0_prologue(F); break;
        case PT_NORM: norm_phase(F, l, ctx_in); break;
        case PT_FINAL: final_norm_phase(F); break;
        case PT_EIN: {
            Sched3 S; S.G = F.G; S.c = F.bx; S.lda = 1024; S.ldb = 1024;
            const char* H = (const char*)WSP(h16, WS_H); const char* W = (const char*)WSP(h16, WS_WEIN + (size_t)i * SZ_WEIN);
            S.A0 = H; S.B0 = W; S.nM0 = 64; S.nN0 = 7;
            S.A1 = H + (size_t)NLAT * 2048; S.B1 = W; S.nM1 = 8; S.nN1 = need_ctx ? 7 : 3;
            S.A2 = (const char*)WSP(h16, WS_WZ + (size_t)i * SZ_WZ); S.B2 = H; S.nM2 = 2; S.nN2 = need_ctx ? 72 : 64;
            EpiEvenIn E{WSP(h16, WS_UA), WSP(h16, WS_SZ), WSP(h16, WS_ZT), WSP(h16, WS_YB)};
            pg8::gemm_phase(F.lds, F.tid, 1024, 1024, 1024, S, E);
        } break;
        case PT_S5E: {
            SchedS5 S; S.UA = (const char*)WSP(h16, WS_UA); S.W = (const char*)WSP(h16, WS_W1 + (size_t)i * SZ_W1); S.wstride = (size_t)256 * 256 * 2; S.nMt = 5; S.G = F.G; S.c = F.bx;
            EpiS5E E{WSP(h16, WS_UA)};
            pg8::gemm_phase(F.lds, F.tid, 256, UA_LD, 256, S, E);
            fnet_stage_a(F);
        } break;
        case PT_SCAN: {
            Sched3 S; S.G = F.G; S.c = F.bx; S.lda = 512; S.ldb = 512;
            S.A0 = (const char*)WSP(h16, WS_WB); S.B0 = (const char*)WSP(h16, WS_YB); S.nM0 = 1; S.nN0 = need_ctx ? 72 : 64;
            S.A1 = S.A0; S.B1 = S.B0; S.nM1 = 0; S.nN1 = 0; S.A2 = S.A0; S.B2 = S.B0; S.nM2 = 0; S.nN2 = 0;
            EpiFnetB E{WSP(h16, WS_H), WSP(h16, WS_SZ)};
            pg8::gemm_phase(F.lds, F.tid, 512, 512, 512, S, E);
            s5_scan(F, i, 72);
        } break;
        case PT_S5Y: {
            SchedS5 S; S.UA = (const char*)WSP(h16, WS_UA); S.W = (const char*)WSP(h16, WS_W2 + (size_t)i * SZ_W2); S.wstride = (size_t)256 * 512 * 2; S.nMt = need_ctx ? 5 : 4; S.G = F.G; S.c = F.bx;
            EpiS5Y E{WSP(h16, WS_YA)};
            pg8::gemm_phase(F.lds, F.tid, 512, UA_LD, 512, S, E);
        } break;
        case PT_GLU: {
            Sched3 S; S.G = F.G; S.c = F.bx; S.lda = 768; S.ldb = 768;
            const char* A = (const char*)WSP(h16, WS_YA); const char* W = (const char*)WSP(h16, WS_WGLU + (size_t)i * SZ_WGLU);
            S.A0 = A; S.B0 = W; S.nM0 = 64; S.nN0 = 3; S.A1 = A + (size_t)NLAT * 768 * 2; S.B1 = W; S.nM1 = need_ctx ? 8 : 0; S.nN1 = 3; S.A2 = A; S.B2 = W; S.nM2 = 0; S.nN2 = 0;
            EpiGlu E{WSP(h16, WS_H), WSP(h16, WS_YA), WSP(h16, WS_SZ), F.p->in[I_GLUB] + (size_t)i * 768};
            pg8::gemm_phase(F.lds, F.tid, 768, 768, 768, S, E);
        } break;
        case PT_OUT: {
            Sched3 S; S.G = F.G; S.c = F.bx; S.lda = 1024; S.ldb = 1024;
            const char* A = (const char*)WSP(h16, WS_H); const char* W = (const char*)((l & 1) ? WSP(h16, WS_WOOUT + (size_t)i * SZ_WOUT) : WSP(h16, WS_WEOUT + (size_t)i * SZ_WOUT));
            S.A0 = A; S.B0 = W; S.nM0 = 64; S.nN0 = 4; S.A1 = A + (size_t)NLAT * 2048; S.B1 = W; S.nM1 = need_ctx ? 8 : 0; S.nN1 = 4; S.A2 = A; S.B2 = W; S.nM2 = 0; S.nN2 = 0;
            EpiOut E{F.p->out, WSP(float, WS_XC), WSP(float, WS_ADA) + (size_t)l * 9 * 3072};
            pg8::gemm_phase(F.lds, F.tid, 1024, 1024, 1024, S, E);
        } break;
        case PT_OIN: {
            Sched3 S; S.G = F.G; S.c = F.bx; S.lda = 1024; S.ldb = 1024;
            const char* A = (const char*)WSP(h16, WS_H); const char* W = (const char*)WSP(h16, WS_WOIN + (size_t)i * SZ_WOIN);
            S.A0 = A; S.B0 = W; S.nM0 = 64; S.nN0 = 12; S.A1 = A + (size_t)NLAT * 2048; S.B1 = W; S.nM1 = need_ctx ? 8 : 0; S.nN1 = 12; S.A2 = A; S.B2 = W; S.nM2 = 0; S.nN2 = 0;
            EpiOddIn E{WSP(h16, WS_P), WSP(h16, WS_SZ)};
            pg8::gemm_phase(F.lds, F.tid, 1024, 1024, 1024, S, E);
        } break;
        case PT_OMIX: odd_mix_phase(F, i, need_ctx); break;
        default: break;
        }
        if (ph + 1 < prm.ph_hi) xcd_barrier(bar, F.tid == 0);
    }
}

extern "C" void kernel_launch(void* const* d_in, const int* in_sizes, int n_in, void* d_out, int out_size, void* d_ws, size_t ws_size, hipStream_t stream) {
    static int grid = 0;
    if (grid == 0) {
        if (n_in != 26 || out_size != NLAT * D || ws_size < WS_END) { fprintf(stderr, "kernel_launch: unexpected problem (n_in %d out %d ws %zu need %zu)\n", n_in, out_size, ws_size, (size_t)WS_END); grid = -1; return; }
        int dev = 0, cus = 0, per_cu = 0;
        if (hipGetDevice(&dev) != hipSuccess || hipDeviceGetAttribute(&cus, hipDeviceAttributeMultiprocessorCount, dev) != hipSuccess) { grid = -1; return; }
        if (hipFuncSetAttribute((const void*)fwd_kernel, hipFuncAttributeMaxDynamicSharedMemorySize, LDS_BYTES) != hipSuccess) { fprintf(stderr, "kernel_launch: hipFuncSetAttribute failed\n"); grid = -1; return; }
        if (hipOccupancyMaxActiveBlocksPerMultiprocessor(&per_cu, (const void*)fwd_kernel, 512, LDS_BYTES) != hipSuccess || per_cu < 1) { fprintf(stderr, "kernel_launch: occupancy query says %d\n", per_cu); per_cu = 1; }
        (void)hipGetLastError();
        grid = cus;
        if (grid != 256) fprintf(stderr, "kernel_launch: note: %d CUs\n", grid);
    }
    if (grid < 0) return;
    (void)hipMemsetAsync((char*)d_ws + WS_CTL, 0, CTL_BYTES, stream);
    Params p{};
    for (int i = 0; i < 26; ++i) p.in[i] = (const float*)d_in[i];
    p.out = (float*)d_out; p.ws = (unsigned char*)d_ws;
#if MK_ONE_LAUNCH
    p.ph_lo = 0; p.ph_hi = N_PHASES;
    hipLaunchKernelGGL(fwd_kernel, dim3(grid), dim3(512), LDS_BYTES, stream, p);
#else
    for (int ph = 0; ph < N_PHASES; ++ph) { p.ph_lo = ph; p.ph_hi = ph + 1; hipLaunchKernelGGL(fwd_kernel, dim3(grid), dim3(512), LDS_BYTES, stream, p); }
#endif
}
```

```cpp
#include <hip/hip_runtime.h>
#include <cstdio>
#include <cstdint>

#ifndef PROBE_TYPE
#define PROBE_TYPE (-1)
#endif
#ifndef PROBE_REP
#define PROBE_REP 1
#endif
#ifndef MK_ONE_LAUNCH
#define MK_ONE_LAUNCH 1
#endif

#define LAS __attribute__((address_space(3)))
#define GAS __attribute__((address_space(1)))
typedef _Float16 h16;
typedef _Float16 h16x8 __attribute__((ext_vector_type(8)));
typedef _Float16 h16x4 __attribute__((ext_vector_type(4)));
typedef _Float16 h16x2 __attribute__((ext_vector_type(2)));
typedef float f32x4 __attribute__((ext_vector_type(4)));
typedef float f32x2 __attribute__((ext_vector_type(2)));
typedef unsigned u32x4 __attribute__((ext_vector_type(4)));
typedef unsigned u32x2 __attribute__((ext_vector_type(2)));
typedef GAS unsigned gu32;

constexpr int NB = 8, T = 2048, TC = 256, D = 1024;
constexpr int NLAT = NB * T, NCTX = NB * TC, NTOK = NLAT + NCTX;
constexpr int NGRP = 48;
constexpr int UA_ROWS = 1280, UA_LD = 512;
constexpr float SIG1 = 64.f, SIG2 = 1024.f;
constexpr int N_PHASES = 24;

constexpr size_t al256(size_t x) { return (x + 255) & ~size_t(255); }
constexpr size_t WS_CTL = 0, CTL_BYTES = 1u << 20;
constexpr size_t WS_ADA = WS_CTL + CTL_BYTES;
constexpr size_t WS_POS = WS_ADA + al256(4 * 9 * 3072 * 4);
constexpr size_t WS_LAM = WS_POS + al256(96 * 512 * 4);
constexpr size_t WS_WB = WS_LAM + al256(2 * 2 * 48 * 64 * 8);
constexpr size_t WS_XC = WS_WB + al256(256 * 512 * 2);
constexpr size_t WS_H = WS_XC + al256((size_t)NCTX * D * 4);
constexpr size_t WS_SZ = WS_H + al256((size_t)NTOK * D * 2);
constexpr size_t WS_TMP = WS_SZ + al256((size_t)NTOK * D * 2);
constexpr size_t WS_UA = WS_TMP;
constexpr size_t WS_ZT = WS_UA + al256((size_t)NGRP * UA_ROWS * UA_LD * 2);
constexpr size_t WS_YB = WS_ZT + al256((size_t)512 * NLAT * 2);
constexpr size_t WS_YA = WS_ZT;
constexpr size_t WS_P = WS_TMP;
constexpr size_t TMP_BYTES = al256((size_t)NGRP * UA_ROWS * UA_LD * 2) + al256((size_t)512 * NLAT * 2) + al256((size_t)NTOK * 512 * 2);
static_assert((size_t)NTOK * 768 * 2 <= al256((size_t)512 * NLAT * 2) + al256((size_t)NTOK * 512 * 2), "YA alias");
static_assert((size_t)NTOK * 2048 * 2 <= TMP_BYTES, "P alias");
constexpr size_t WS_W = WS_TMP + TMP_BYTES;
constexpr size_t SZ_WEIN = (size_t)1792 * 1024 * 2, SZ_WZ = (size_t)512 * 1024 * 2, SZ_WGLU = (size_t)768 * 768 * 2, SZ_WOUT = (size_t)1024 * 1024 * 2;
constexpr size_t SZ_WOIN = (size_t)3072 * 1024 * 2, SZ_W1 = (size_t)NGRP * 256 * 256 * 2, SZ_W2 = (size_t)NGRP * 256 * 512 * 2;
constexpr size_t WS_WEIN = WS_W, WS_WZ = WS_WEIN + 2 * SZ_WEIN, WS_WGLU = WS_WZ + 2 * SZ_WZ, WS_WEOUT = WS_WGLU + 2 * SZ_WGLU, WS_WOIN = WS_WEOUT + 2 * SZ_WOUT;
constexpr size_t WS_WOOUT = WS_WOIN + 2 * SZ_WOIN, WS_W1 = WS_WOOUT + 2 * SZ_WOUT, WS_W2 = WS_W1 + 2 * SZ_W1, WS_END = WS_W2 + 2 * SZ_W2;
static_assert(WS_END <= (size_t)268435456, "workspace map exceeds 256 MiB");

constexpr int RING_BYTES = 131072, MISC_OFF = 143360, LDS_BYTES = 147456;

__device__ __forceinline__ unsigned pkh(float lo, float hi) { h16x2 v; v.x = (h16)lo; v.y = (h16)hi; return __builtin_bit_cast(unsigned, v); }
__device__ __forceinline__ f32x2 unpkh(unsigned w) { h16x2 v = __builtin_bit_cast(h16x2, w); return (f32x2){(float)v.x, (float)v.y}; }
__device__ __forceinline__ float sigmoidf_(float x) { return __builtin_amdgcn_rcpf(1.0f + __expf(-x)); }
__device__ __forceinline__ float siluf_(float x) { return x * sigmoidf_(x); }
__device__ __forceinline__ float gelu_tanh_(float x) { const float u = 0.7978845608028654f * (x + 0.044715f * x * x * x); return x * sigmoidf_(2.0f * u); }
#define SWZ_XOR(v, k) __builtin_bit_cast(float, __builtin_amdgcn_ds_swizzle(__builtin_bit_cast(int, (float)(v)), 0x1f | ((k) << 10)))
__device__ __forceinline__ float xor32(float v, int lane) { return __builtin_bit_cast(float, __builtin_amdgcn_ds_bpermute((lane ^ 32) << 2, __builtin_bit_cast(int, v))); }
__device__ __forceinline__ float wave_sum(float v, int lane) {
    v += SWZ_XOR(v, 1); v += SWZ_XOR(v, 2); v += SWZ_XOR(v, 4); v += SWZ_XOR(v, 8); v += SWZ_XOR(v, 16);
    return v + xor32(v, lane);
}
#define LDS_WAIT() asm volatile("s_waitcnt lgkmcnt(0)" ::: "memory")
#define VM_WAIT() asm volatile("s_waitcnt vmcnt(0)" ::: "memory")

namespace pg8 {
constexpr int BM = 256, BK = 64, HALF = 128, HTB = HALF * BK * 2, STAGE_BYTES = 8 * HTB;
__device__ __forceinline__ int lds_byte(int r, int c) { const int st = (r >> 4) * 2 + (c >> 5), rr = r & 15, cc = c & 31, ob = rr * 64 + cc * 2; return st * 1024 + (ob ^ (((ob >> 9) & 1) << 5)); }
__device__ __forceinline__ void stage_rc(int b, int& R, int& C) { const int st = b / 1024, sb = b % 1024, swz = sb ^ (((sb >> 9) & 1) << 5); R = (st >> 1) * 16 + swz / 64; C = (st & 1) * 32 + (swz % 64) / 2; }
__device__ __forceinline__ int perm32(int rho) { const int n = rho >> 4, i = rho & 15; return 8 * (i >> 2) + 4 * n + (i & 3); }
struct Unit { const char* a; const char* b; int job, pm, pn, aux; };
typedef f32x4 Acc[2][2][4][2];

template <class Epi, class Sched>
__device__ __forceinline__ void gemm_phase(LAS unsigned char* lds, const int tid, const int K, const int lda, const int ldb, const Sched& S, const Epi& E) {
    const int wid = __builtin_amdgcn_readfirstlane(tid >> 6), lane = tid & 63, wr = wid >> 2, wc = wid & 3, fr = lane & 15, fq = lane >> 4;
    int nt = K / BK; asm volatile("" : "+s"(nt));
    unsigned voffA[2], voffB[2];
#pragma unroll
    for (int i = 0; i < 2; ++i) { int R, C; stage_rc(tid * 16 + i * 8192, R, C); const int Rb = (R & ~31) + perm32(R & 31);
        voffA[i] = (unsigned)(R * lda + C) * 2u; voffB[i] = (unsigned)(Rb * ldb + C) * 2u; }
    const size_t kstep = (size_t)(BK * 2);
    const size_t hstepA = (size_t)HALF * lda * 2, hstepB = (size_t)HALF * ldb * 2;
    const unsigned ldsw = (unsigned)wid * 1024u;
    const int aoff = lds_byte(wr * 64 + fr, fq * 8), boff = lds_byte(wc * 32 + fr, fq * 8);
#define PG8_SA(b, h) (((b) * 2 + (h)) * HTB)
#define PG8_SB(b, h) ((4 + (b) * 2 + (h)) * HTB)
#define PG8_STAGE(bufoff, gbase, voff) do { _Pragma("unroll") for (int _i = 0; _i < 2; ++_i) \
        __builtin_amdgcn_global_load_lds((const unsigned*)((const char*)(gbase) + (voff)[_i]), (LAS unsigned*)(lds + (bufoff) + ldsw + _i * 8192), 16, 0, 0); } while (0)
#define PG8_LDA(dst, b, h) do { _Pragma("unroll") for (int m = 0; m < 4; ++m) _Pragma("unroll") for (int k = 0; k < 2; ++k) dst[m][k] = *(const LAS h16x8*)(lds + PG8_SA(b, h) + aoff + m * 2048 + k * 1024); } while (0)
#define PG8_LDB(dst, b, h) do { _Pragma("unroll") for (int n = 0; n < 2; ++n) _Pragma("unroll") for (int k = 0; k < 2; ++k) dst[n][k] = *(const LAS h16x8*)(lds + PG8_SB(b, h) + boff + n * 2048 + k * 1024); } while (0)
#define PG8_MMA(ai, bj, At, Bt) do { __builtin_amdgcn_s_setprio(1); _Pragma("unroll") for (int m = 0; m < 4; ++m) _Pragma("unroll") for (int n = 0; n < 2; ++n) _Pragma("unroll") for (int k = 0; k < 2; ++k) \
        acc[ai][bj][m][n] = __builtin_amdgcn_mfma_f32_16x16x32_f16(Bt[n][k], At[m][k], acc[ai][bj][m][n], 0, 0, 0); __builtin_amdgcn_s_setprio(0); } while (0)
#define PG8_WAIT_V(n) asm volatile("s_waitcnt vmcnt(" #n ")" ::: "memory")
#define PG8_WAIT_L(n) asm volatile("s_waitcnt lgkmcnt(" #n ")" ::: "memory")
#define PG8_BAR __builtin_amdgcn_s_barrier()
#define PG8_SCHED __builtin_amdgcn_sched_barrier(0)
    Unit cur, nxt; int ui = 0;
    if (!S.next(0, cur)) return;
    Acc acc;
#pragma unroll
    for (int a = 0; a < 2; ++a)
#pragma unroll
        for (int b = 0; b < 2; ++b)
#pragma unroll
            for (int m = 0; m < 4; ++m)
#pragma unroll
                for (int n = 0; n < 2; ++n) acc[a][b][m][n] = (f32x4){0.f, 0.f, 0.f, 0.f};
    h16x8 At[4][2], B0[2][2], B1[2][2];
    const char* cA = cur.a; const char* cB = cur.b;
    PG8_STAGE(PG8_SB(0, 0), cB, voffB); PG8_STAGE(PG8_SB(0, 1), cB + hstepB, voffB); PG8_STAGE(PG8_SA(0, 0), cA, voffA); PG8_STAGE(PG8_SA(0, 1), cA + hstepA, voffA);
    if (wr == 1) PG8_BAR;
    PG8_WAIT_V(2); PG8_BAR;
    PG8_STAGE(PG8_SB(1, 0), cB + kstep, voffB); PG8_STAGE(PG8_SA(1, 0), cA + kstep, voffA); PG8_STAGE(PG8_SB(1, 1), cB + hstepB + kstep, voffB);
    PG8_WAIT_V(6); PG8_BAR;
    for (;;) {
        const bool has_next = S.next(ui + 1, nxt);
        const char* nA = has_next ? nxt.a : cA; const char* nB = has_next ? nxt.b : cB;
        for (int t = 0; t < nt; t += 2) {
            const bool last = (t == nt - 2);
            const char* a1 = cA + (size_t)(t + 1) * kstep;
            const char* a2 = last ? nA : cA + (size_t)(t + 2) * kstep; const char* b2 = last ? nB : cB + (size_t)(t + 2) * kstep;
            const char* a3 = a2 + kstep; const char* b3 = b2 + kstep;
            PG8_LDB(B0, 0, 0); PG8_LDB(B1, 0, 1); PG8_SCHED; PG8_LDA(At, 0, 0); PG8_STAGE(PG8_SA(1, 1), a1 + hstepA, voffA);
            PG8_WAIT_V(8); PG8_WAIT_L(0); PG8_BAR; PG8_MMA(0, 0, At, B0); PG8_MMA(0, 1, At, B1); PG8_BAR; PG8_SCHED;
            PG8_LDA(At, 0, 1); PG8_STAGE(PG8_SB(0, 0), b2, voffB); PG8_STAGE(PG8_SB(0, 1), b2 + hstepB, voffB); PG8_STAGE(PG8_SA(0, 0), a2, voffA);
            PG8_WAIT_V(8); PG8_WAIT_L(0); PG8_BAR; PG8_MMA(1, 0, At, B0); PG8_MMA(1, 1, At, B1); PG8_BAR; PG8_SCHED;
            PG8_LDB(B0, 1, 0); PG8_LDB(B1, 1, 1); PG8_SCHED; PG8_LDA(At, 1, 0); PG8_STAGE(PG8_SA(0, 1), a2 + hstepA, voffA);
            PG8_WAIT_V(8); PG8_WAIT_L(0); PG8_BAR; PG8_MMA(0, 0, At, B0); PG8_MMA(0, 1, At, B1); PG8_BAR; PG8_SCHED;
            PG8_LDA(At, 1, 1); PG8_STAGE(PG8_SB(1, 0), b3, voffB); PG8_STAGE(PG8_SB(1, 1), b3 + hstepB, voffB); PG8_STAGE(PG8_SA(1, 0), a3, voffA);
            PG8_WAIT_V(8); PG8_WAIT_L(0); PG8_BAR; PG8_MMA(1, 0, At, B0); PG8_MMA(1, 1, At, B1); PG8_BAR; PG8_SCHED;
        }
        if (wr == 0) PG8_BAR;
        E(acc, cur, wr, wc, fr, fq);
        if (!has_next) break;
#pragma unroll
        for (int a = 0; a < 2; ++a)
#pragma unroll
            for (int b = 0; b < 2; ++b)
#pragma unroll
                for (int m = 0; m < 4; ++m)
#pragma unroll
                    for (int n = 0; n < 2; ++n) acc[a][b][m][n] = (f32x4){0.f, 0.f, 0.f, 0.f};
        cur = nxt; cA = nA; cB = nB; ++ui;
        if (wr == 1) PG8_BAR;
    }
    PG8_WAIT_V(0);
    PG8_BAR;
#undef PG8_SA
#undef PG8_SB
#undef PG8_STAGE
#undef PG8_LDA
#undef PG8_LDB
#undef PG8_MMA
#undef PG8_WAIT_V
#undef PG8_WAIT_L
#undef PG8_BAR
#undef PG8_SCHED
}
__device__ __forceinline__ int xcd_remap(int L, int nwg) { const int q = nwg / 8, r = nwg % 8, xcd = L % 8, off = L / 8; return (xcd < r ? xcd * (q + 1) : r * (q + 1) + (xcd - r) * q) + off; }
__device__ __forceinline__ void tile_of(int wgid, int nM, int nN, int& pm, int& pn) { const int nig = 8 * nN, gid = wgid / nig, fm = gid * 8, gsz = (nM - fm) < 8 ? (nM - fm) : 8; pm = fm + ((wgid % nig) % gsz); pn = (wgid % nig) / gsz; }
}
using pg8::Unit; using pg8::Acc;

#define XB_TMO      128
#define XB_XCNT(j)  (256  + 64 * (j))
#define XB_XSUB(j)  (1280 + 64 * (j))
#define XB_XGEN(j)  (2304 + 64 * (j))
#define XB_TOP      3328
#define XB_TOPGEN   3392
#define XCD_BAR_WORDS 3456
#define XB_SPIN_CAP (1u << 20)
__device__ __forceinline__ unsigned xb_ld(unsigned* p)              { return __hip_atomic_load(p, __ATOMIC_RELAXED, __HIP_MEMORY_SCOPE_AGENT); }
__device__ __forceinline__ unsigned xb_add(unsigned* p, unsigned v) { return __hip_atomic_fetch_add(p, v, __ATOMIC_RELAXED, __HIP_MEMORY_SCOPE_AGENT); }
__device__ __forceinline__ unsigned xb_xcc_id() { return (unsigned)__builtin_amdgcn_s_getreg((3 << 11) | 20) & 0xFu; }
#define XB_SPIN(cond, bar) do { unsigned _sp = 0; while (cond) { __builtin_amdgcn_s_sleep(1); \
    if ((++_sp & 255u) == 0u) { if (xb_ld(&(bar)[XB_TMO])) break; if (_sp > XB_SPIN_CAP) { atomicAdd(&(bar)[XB_TMO], 1u); break; } } } } while (0)
struct XcdBarrier { unsigned* bar; unsigned x; volatile LAS unsigned* st; };
__device__ __forceinline__ XcdBarrier xcd_barrier_post(unsigned* bar, volatile LAS unsigned* st, bool t0) {
    XcdBarrier b; b.bar = bar; b.x = xb_xcc_id(); b.st = st;
    if (t0) (void)xb_add(&bar[XB_XCNT(b.x)], 1u);
    return b;
}
__device__ __forceinline__ void xcd_barrier_complete(unsigned* bar, unsigned x, unsigned& nloc, unsigned& nx) {
    const unsigned G = gridDim.x * gridDim.y * gridDim.z;
    unsigned sum, cnt, mine, sp = 0u;
    for (;;) {
        sum = 0u; cnt = 0u; mine = 0u;
#pragma unroll
        for (unsigned j = 0; j < 16; ++j) { const unsigned c = xb_ld(&bar[XB_XCNT(j)]); sum += c; cnt += (c > 0u) ? 1u : 0u; mine = (j == x) ? c : mine; }
        if (sum == G) break;
        __builtin_amdgcn_s_sleep(1);
        if ((++sp & 255u) == 0u) { if (xb_ld(&bar[XB_TMO])) break; if (sp > XB_SPIN_CAP) { atomicAdd(&bar[XB_TMO], 1u); break; } }
    }
    nloc = mine > 0u ? mine : 1u; nx = cnt > 0u ? cnt : 1u;
}
__device__ __forceinline__ void xcd_barrier(const XcdBarrier& b, bool t0) {
    asm volatile("s_waitcnt vmcnt(0)" ::: "memory");
    __syncthreads();
    if (t0) {
        unsigned* bar = b.bar;
        __builtin_amdgcn_s_waitcnt(0);
        unsigned nloc = b.st[0], nx = b.st[1];
        if (nloc == 0u) { xcd_barrier_complete(bar, b.x, nloc, nx); b.st[0] = nloc; b.st[1] = nx; }
        const unsigned old = xb_add(&bar[XB_XSUB(b.x)], 1u);
        const unsigned gen = old / nloc;
        if (old + 1u == (gen + 1u) * nloc) {
            __builtin_amdgcn_fence(__ATOMIC_RELEASE, "agent");
            asm volatile("s_waitcnt vmcnt(0)" ::: "memory");
            const unsigned og = xb_add(&bar[XB_TOP], 1u);
            const unsigned tg = og / nx;
            if (og + 1u == (tg + 1u) * nx) xb_add(&bar[XB_TOPGEN], 1u);
            else XB_SPIN(xb_ld(&bar[XB_TOPGEN]) == tg, bar);
            __builtin_amdgcn_fence(__ATOMIC_ACQUIRE, "agent");
            xb_add(&bar[XB_XGEN(b.x)], 1u);
            asm volatile("s_waitcnt vmcnt(0)" ::: "memory");
        } else {
            XB_SPIN(xb_ld(&bar[XB_XGEN(b.x)]) == gen, bar);
            __builtin_amdgcn_fence(__ATOMIC_ACQUIRE, "agent");
            asm volatile("s_waitcnt vmcnt(0)" ::: "memory");
        }
    }
    __syncthreads();
}

struct Params { const float* in[26]; float* out; unsigned char* ws; int ph_lo, ph_hi; };
enum { I_X = 0, I_C, I_CTX, I_CCTX, I_NORMG, I_ADAW, I_ADAB, I_EWIN, I_EWOUT, I_LAMRE, I_LAMIM, I_LOGSTEP, I_BRE, I_BIM, I_CRE, I_CIM, I_S5D, I_GLUW, I_GLUB, I_FNETW,
       I_OWIN, I_OWOUT, I_POOLW, I_POOLS, I_CONVW, I_FINALG };
struct Frame {
    LAS unsigned char* lds;
    int tid, lane, wave, vcu, G, bx;
    const Params* p;
    unsigned char* ws;
};
#define WSP(T, off) ((T*)(F.ws + (off)))

__device__ __forceinline__ void p0_transpose_item(const float* W, int K, int N, int n_src0, int nblk, h16* WT, int row_off, LAS float* scr, int item, int lane) {
    const int kb = item / nblk, nb = item % nblk, k0 = 64 * kb, n0 = 32 * nb;
    float tv[32];
#pragma unroll
    for (int i = 0; i < 32; ++i) { const int kk = 2 * i + (lane >> 5); tv[i] = W[(size_t)(k0 + kk) * N + n_src0 + n0 + (lane & 31)]; }
#pragma unroll
    for (int i = 0; i < 32; ++i) { const int kk = 2 * i + (lane >> 5); scr[kk * 33 + (lane & 31)] = tv[i]; }
    LDS_WAIT(); asm volatile("" ::: "memory");
    const int c = lane & 7;
#pragma unroll
    for (int j = 0; j < 4; ++j) { const int n = (lane >> 3) + 8 * j; const LAS float* s = scr + (8 * c) * 33 + n;
        u32x4 o; o.x = pkh(s[0 * 33], s[1 * 33]); o.y = pkh(s[2 * 33], s[3 * 33]); o.z = pkh(s[4 * 33], s[5 * 33]); o.w = pkh(s[6 * 33], s[7 * 33]);
        *(u32x4*)(WT + (size_t)(row_off + n0 + n) * K + k0 + 8 * c) = o; }
    LDS_WAIT(); asm volatile("" ::: "memory");
}
typedef f32x2 cf;
__device__ __forceinline__ cf cmul(cf a, cf b) { return (cf){a.x * b.x - a.y * b.y, a.x * b.y + a.y * b.x}; }
__device__ __forceinline__ cf lam_pow(float lr, float li, float step, int m) {
    const float mag = expf(lr * step * (float)m);
    const double ang = (double)li * (double)step * (double)m * 0.15915494309189535;
    const double fr = ang - __builtin_rint(ang);
    float s, c; sincospif((float)(2.0 * fr), &s, &c);
    return (cf){mag * c, mag * s};
}
__device__ __forceinline__ cf zoh_coef(float lr, float li, float step, cf lamb) {
    const cf z = (cf){lr * step, li * step};
    const float az2 = z.x * z.x + z.y * z.y;
    if (az2 < 0.0625f) {
        cf acc = (cf){1.f, 0.f}, term = (cf){1.f, 0.f};
#pragma unroll
        for (int n = 2; n <= 10; ++n) { term = cmul(term, z) * (1.0f / n); acc += term; }
        return acc * step;
    }
    const cf num = (cf){lamb.x - 1.0f, lamb.y};
    const float den = 1.0f / (lr * lr + li * li);
    return (cf){(num.x * lr + num.y * li) * den, (num.y * lr - num.x * li) * den};
}
__device__ __forceinline__ void p0_s5_item(Frame& F, int i, int g) {
    const Params& P = *F.p;
    LAS cf* pw = (LAS cf*)(F.lds);
    LAS cf* bb = (LAS cf*)(F.lds + 17408);
    LAS cf* cc = (LAS cf*)(F.lds + 17408 + 16384);
    LAS float* kt = (LAS float*)(F.lds + 17408 + 32768);
    const int tid = F.tid;
    const size_t sgp = ((size_t)i * 2) * NGRP * 64;
    for (int e = tid; e < 2 * 17 * 64; e += 512) { const int dir = e / (17 * 64), m = (e / 64) % 17, p = e & 63;
        const size_t ix = sgp + ((size_t)dir * NGRP + g) * 64 + p;
        const float step = expf(P.in[I_LOGSTEP][((size_t)i * 2 + dir) * NGRP + g]);
        pw[e] = lam_pow(P.in[I_LAMRE][ix], P.in[I_LAMIM][ix], step, m); }
    __syncthreads();
    for (int e = tid; e < 2 * 64 * 16; e += 512) { const int dir = e / 1024, p = (e / 16) & 63, h = e & 15;
        const size_t ix = sgp + ((size_t)dir * NGRP + g) * 64 + p;
        const float step = expf(P.in[I_LOGSTEP][((size_t)i * 2 + dir) * NGRP + g]);
        const cf co = zoh_coef(P.in[I_LAMRE][ix], P.in[I_LAMIM][ix], step, pw[(dir * 17 + 1) * 64 + p]);
        const size_t bx = ix * 16 + h;
        bb[e] = cmul(co, (cf){P.in[I_BRE][bx], P.in[I_BIM][bx]});
        const int ho = (e / 64) & 15, p2 = e & 63;
        const size_t cx = ((((size_t)i * 2 + dir) * NGRP + g) * 16 + ho) * 64 + p2;
        cc[e] = (cf){P.in[I_CRE][cx], P.in[I_CIM][cx]}; }
    __syncthreads();
    {
        const int dir = tid >> 8, ho = (tid >> 4) & 15, hi = tid & 15;
        float kacc[16];
#pragma unroll
        for (int m = 0; m < 16; ++m) kacc[m] = 0.f;
        for (int p = 0; p < 64; ++p) { const cf q = cmul(cc[(dir * 16 + ho) * 64 + p], bb[(dir * 64 + p) * 16 + hi]);
#pragma unroll
            for (int m = 0; m < 16; ++m) { const cf w = pw[(dir * 17 + m) * 64 + p]; kacc[m] += q.x * w.x - q.y * w.y; } }
#pragma unroll
        for (int m = 0; m < 16; ++m) kt[((dir * 16 + m) * 16 + ho) * 16 + hi] = kacc[m];
    }
    __syncthreads();
    h16* W1 = WSP(h16, WS_W1 + (size_t)i * SZ_W1) + (size_t)g * 256 * 256;
    h16* W2 = WSP(h16, WS_W2 + (size_t)i * SZ_W2) + (size_t)g * 256 * 512;
    const float* dsk = P.in[I_S5D] + ((size_t)i * NGRP + g) * 16;
    for (int e = tid; e < 256 * 32; e += 512) { const int n = e >> 5, k0 = (e & 31) * 8, dir = n >> 7, p = (n & 127) >> 1, ri = n & 1, j = k0 >> 4, h0 = k0 & 15;
        const cf w = pw[(dir * 17 + (dir == 0 ? 15 - j : j)) * 64 + p]; float v[8];
#pragma unroll
        for (int q = 0; q < 8; ++q) { const cf t = cmul(w, bb[(dir * 64 + p) * 16 + h0 + q]); v[q] = SIG1 * (ri ? t.y : t.x); }
        u32x4 o; o.x = pkh(v[0], v[1]); o.y = pkh(v[2], v[3]); o.z = pkh(v[4], v[5]); o.w = pkh(v[6], v[7]);
        *(u32x4*)(W1 + (size_t)n * 256 + k0) = o; }
    for (int e = tid; e < 256 * 64; e += 512) { const int n = e >> 6, c0 = (e & 63) * 8, k = n >> 4, ho = n & 15; float v[8];
        if (c0 < 256) { const int j = c0 >> 4, hi0 = c0 & 15;
#pragma unroll
            for (int q = 0; q < 8; ++q) { const int hi = hi0 + q; float x;
                if (k > j) x = kt[((0 * 16 + (k - j)) * 16 + ho) * 16 + hi];
                else if (j > k) x = kt[((1 * 16 + (j - k)) * 16 + ho) * 16 + hi];
                else x = kt[((0 * 16 + 0) * 16 + ho) * 16 + hi] + kt[((1 * 16 + 0) * 16 + ho) * 16 + hi] + (ho == hi ? dsk[ho] : 0.f);
                v[q] = SIG2 * x; }
        } else { const int dir = (c0 - 256) >> 7, p0 = ((c0 - 256) & 127) >> 1, m = (dir == 0) ? k + 1 : 16 - k;
#pragma unroll
            for (int q = 0; q < 4; ++q) { const cf t = cmul(cc[(dir * 16 + ho) * 64 + p0 + q], pw[(dir * 17 + m) * 64 + p0 + q]);
                v[2 * q] = (SIG2 / SIG1) * t.x; v[2 * q + 1] = -(SIG2 / SIG1) * t.y; } }
        u32x4 o; o.x = pkh(v[0], v[1]); o.y = pkh(v[2], v[3]); o.z = pkh(v[4], v[5]); o.w = pkh(v[6], v[7]);
        *(u32x4*)(W2 + (size_t)n * 512 + c0) = o; }
    if (tid < 128) { const int dir = tid >> 6, p = tid & 63; const cf w = pw[(dir * 17 + 16) * 64 + p];
        WSP(f32x2, WS_LAM)[(((size_t)i * 2 + dir) * NGRP + g) * 64 + p] = w; }
    __syncthreads();
}
__device__ __forceinline__ void p0_fnet_item(Frame& F, int item) {
    const Params& P = *F.p;
    const int kq = item & 3, g = (item >> 2) & 3, trig = (item >> 4) & 1, i = item >> 5, tid = F.tid;
    LAS float* M = (LAS float*)F.lds;
    LAS float* tab = (LAS float*)(F.lds + 16384);
    LAS float* As = (LAS float*)(F.lds + 16384 + 256);
    if (tid < 64) { float s, c; sincospif((float)tid * (1.0f / 32.0f), &s, &c); tab[tid] = trig ? s : c; }
    const float* w = P.in[I_EWIN] + (size_t)i * 1024 * 2048 + 768 + g * 64 + (size_t)(kq * 256) * 2048;
    for (int e = tid; e < 256 * 16; e += 512) { const int k = e >> 4, c4 = e & 15; *(LAS f32x4*)(As + k * 68 + 4 * c4) = *(const f32x4*)(w + (size_t)k * 2048 + 4 * c4); }
    __syncthreads();
    const float* fw = P.in[I_FNETW] + ((size_t)i * 4 + g) * 4096;
    for (int e = tid; e < 4096; e += 512) { const int c = e >> 6, d = e & 63; float a = 0.f;
        for (int m = 0; m < 64; ++m) a += tab[(c * m) & 63] * fw[m * 64 + d];
        M[e] = a; }
    __syncthreads();
    const int d4 = tid & 15, k8 = tid >> 4;
    f32x4 o[8];
#pragma unroll
    for (int q = 0; q < 8; ++q) o[q] = (f32x4){0.f, 0.f, 0.f, 0.f};
    for (int c = 0; c < 64; c += 4) {
        f32x4 b[4];
#pragma unroll
        for (int cc = 0; cc < 4; ++cc) b[cc] = *(const LAS f32x4*)(M + (c + cc) * 64 + 4 * d4);
#pragma unroll
        for (int q = 0; q < 8; ++q) { const f32x4 a = *(const LAS f32x4*)(As + (k8 * 8 + q) * 68 + c); o[q] += b[0] * a.x + b[1] * a.y + b[2] * a.z + b[3] * a.w; }
    }
    h16* dst = WSP(h16, WS_WZ + (size_t)i * SZ_WZ) + (size_t)(trig * 256 + g * 64 + 4 * d4) * 1024 + kq * 256 + k8 * 8;
#pragma unroll
    for (int dd = 0; dd < 4; ++dd) { u32x4 a; a.x = pkh(o[0][dd], o[1][dd]); a.y = pkh(o[2][dd], o[3][dd]); a.z = pkh(o[4][dd], o[5][dd]); a.w = pkh(o[6][dd], o[7][dd]); *(u32x4*)(dst + (size_t)dd * 1024) = a; }
    __syncthreads();
}
__device__ __forceinline__ void p0_pool_item(Frame& F, int item) {
    const Params& P = *F.p;
    const int ks = item & 7, g = (item >> 3) & 3, i = item >> 5, tid = F.tid;
    LAS float* Bs = (LAS float*)F.lds;
    LAS float* As = (LAS float*)(F.lds + 65536);
    const float* pwg = P.in[I_POOLW] + ((size_t)i * 4 + g) * 16384;
    for (int e = tid; e < 4096; e += 512) *(LAS f32x4*)(Bs + 4 * e) = *(const f32x4*)(pwg + 4 * e);
    const float* w = P.in[I_OWIN] + (size_t)i * 1024 * 3072 + g * 128 + (size_t)(ks * 128) * 3072;
    for (int e = tid; e < 128 * 32; e += 512) { const int k = e >> 5, c4 = e & 31; *(LAS f32x4*)(As + k * 132 + 4 * c4) = *(const f32x4*)(w + (size_t)k * 3072 + 4 * c4); }
    __syncthreads();
    const int d4 = tid & 31, k8 = tid >> 5;
    f32x4 o[8];
#pragma unroll
    for (int q = 0; q < 8; ++q) o[q] = (f32x4){0.f, 0.f, 0.f, 0.f};
    for (int c = 0; c < 128; c += 4) {
        f32x4 b[4];
#pragma unroll
        for (int cc = 0; cc < 4; ++cc) b[cc] = *(const LAS f32x4*)(Bs + (c + cc) * 128 + 4 * d4);
#pragma unroll
        for (int q = 0; q < 8; ++q) { const f32x4 a = *(const LAS f32x4*)(As + (k8 * 8 + q) * 132 + c); o[q] += b[0] * a.x + b[1] * a.y + b[2] * a.z + b[3] * a.w; }
    }
    const f32x4 sc = *(const f32x4*)(P.in[I_POOLS] + (size_t)i * 512 + g * 128 + 4 * d4);
    h16* dst = WSP(h16, WS_WOIN + (size_t)i * SZ_WOIN) + (size_t)(g * 128 + 4 * d4) * 1024 + ks * 128 + k8 * 8;
#pragma unroll
    for (int dd = 0; dd < 4; ++dd) { const float sv = sc[dd]; u32x4 a; a.x = pkh(o[0][dd] * sv, o[1][dd] * sv); a.y = pkh(o[2][dd] * sv, o[3][dd] * sv); a.z = pkh(o[4][dd] * sv, o[5][dd] * sv); a.w = pkh(o[6][dd] * sv, o[7][dd] * sv);
        *(u32x4*)(dst + (size_t)dd * 1024) = a; }
    __syncthreads();
}
__device__ __forceinline__ void p0_ada_item(Frame& F, int item) {
    const Params& P = *F.p;
    const int l = item / 48, n0 = (item % 48) * 64, tid = F.tid, w = F.wave, lane = F.lane;
    LAS float* sc = (LAS float*)F.lds;
    LAS float* red = (LAS float*)(F.lds + 36864);
    for (int e = tid; e < 9 * 1024; e += 512) { const int r = e >> 10, k = e & 1023; const float v = (r < 8) ? P.in[I_C][r * 1024 + k] : P.in[I_CCTX][k]; sc[e] = siluf_(v); }
    __syncthreads();
    const int kq = lane >> 4, nq = lane & 15;
    const float* wp = P.in[I_ADAW] + (size_t)l * 1024 * 3072 + n0 + 4 * nq;
    f32x4 acc[9];
#pragma unroll
    for (int r = 0; r < 9; ++r) acc[r] = (f32x4){0.f, 0.f, 0.f, 0.f};
#pragma unroll 8
    for (int it = 0; it < 32; ++it) { const int k = w * 128 + it * 4 + kq; const f32x4 wv = *(const f32x4*)(wp + (size_t)k * 3072);
#pragma unroll
        for (int r = 0; r < 9; ++r) acc[r] += wv * sc[r * 1024 + k]; }
#pragma unroll
    for (int r = 0; r < 9; ++r)
#pragma unroll
        for (int j = 0; j < 4; ++j) { float v = acc[r][j]; v += SWZ_XOR(v, 16); v += xor32(v, lane); acc[r][j] = v; }
    if (kq == 0) {
#pragma unroll
        for (int r = 0; r < 9; ++r)
#pragma unroll
            for (int j = 0; j < 4; ++j) red[(w * 16 + nq) * 36 + r * 4 + j] = acc[r][j]; }
    __syncthreads();
    for (int e = tid; e < 576; e += 512) { const int r = e / 64, col = e % 64, q = col >> 2, j = col & 3; float s = 0.f;
#pragma unroll
        for (int ww = 0; ww < 8; ++ww) s += red[(ww * 16 + q) * 36 + r * 4 + j];
        WSP(float, WS_ADA)[((size_t)l * 9 + r) * 3072 + n0 + col] = s + P.in[I_ADAB][(size_t)l * 3072 + n0 + col]; }
    __syncthreads();
}
__device__ __forceinline__ void p0_prologue(Frame& F) {
    const Params& P = *F.p;
    unsigned* ctr = (unsigned*)(F.ws + WS_CTL) + 64;
    volatile LAS unsigned* slot = (volatile LAS unsigned*)(F.lds + MISC_OFF + 64);
    constexpr int I_EIN = 16 * 56, I_GLU = 12 * 24, I_EO = 16 * 32, I_OIN = 16 * 80, I_OO = 16 * 32, I_LAYER = I_EIN + I_GLU + I_EO + I_OIN + I_OO;
    constexpr int N_TR = (2 * I_LAYER + 7) / 8;
    constexpr int Q_S5 = 96, Q_ADA = Q_S5 + 192, Q_POOL = Q_ADA + 64, Q_FNET = Q_POOL + 64, Q_TAB = Q_FNET + 8, Q_END = Q_TAB + N_TR;
    for (;;) {
        __syncthreads();
        if (F.tid == 0) slot[0] = __hip_atomic_fetch_add(ctr, 1u, __ATOMIC_RELAXED, __HIP_MEMORY_SCOPE_AGENT);
        __syncthreads();
        const int it = (int)slot[0];
        if (it >= Q_END) break;
        if (it < Q_S5) p0_s5_item(F, it / 48, it % 48);
        else if (it < Q_ADA) p0_ada_item(F, it - Q_S5);
        else if (it < Q_POOL) p0_pool_item(F, it - Q_ADA);
        else if (it < Q_FNET) p0_fnet_item(F, it - Q_POOL);
        else if (it < Q_TAB) { const int q = it - Q_FNET;
            for (int e = q * 512 + F.tid; e < 256 * 512; e += 8 * 512) { const int k2 = e >> 9, c = e & 511, t2 = c & 255; float s, co; sincospif((float)((k2 * t2) & 255) * (1.0f / 128.0f), &s, &co);
                WSP(h16, WS_WB)[e] = (h16)(c < 256 ? co : s); }
            for (int e = q * 512 + F.tid; e < 96 * 512; e += 8 * 512) { const int r = e >> 9, qq = e & 511, k = qq & 255; const float rr = (float)(r < 32 ? r : r - 32);
                const float om = expf(-(float)k * (9.210340371976184f / 256.0f));
                const double rev = (double)rr * (double)om * 0.15915494309189535; const double fr = rev - __builtin_rint(rev);
                float s, co; sincospif((float)(2.0 * fr), &s, &co);
                WSP(float, WS_POS)[e] = (qq < 256) ? s : co; }
        } else {
            const int wi = (it - Q_TAB) * 8 + F.wave;
            if (wi < 2 * I_LAYER) {
                LAS float* scr = (LAS float*)(F.lds + F.wave * 16384);
                const int i = wi / I_LAYER; int r = wi % I_LAYER;
                if (r < I_EIN) { const int nb = r % 56; const int n_src0 = (nb < 24) ? 0 : 256;
                    p0_transpose_item(P.in[I_EWIN] + (size_t)i * 1024 * 2048, 1024, 2048, n_src0, 56, WSP(h16, WS_WEIN + (size_t)i * SZ_WEIN), 0, scr, r, F.lane); }
                else if ((r -= I_EIN) < I_GLU) p0_transpose_item(P.in[I_GLUW] + (size_t)i * 768 * 768, 768, 768, 0, 24, WSP(h16, WS_WGLU + (size_t)i * SZ_WGLU), 0, scr, r, F.lane);
                else if ((r -= I_GLU) < I_EO) p0_transpose_item(P.in[I_EWOUT] + (size_t)i * 1024 * 1024, 1024, 1024, 0, 32, WSP(h16, WS_WEOUT + (size_t)i * SZ_WOUT), 0, scr, r, F.lane);
                else if ((r -= I_EO) < I_OIN) p0_transpose_item(P.in[I_OWIN] + (size_t)i * 1024 * 3072, 1024, 3072, 512, 80, WSP(h16, WS_WOIN + (size_t)i * SZ_WOIN), 512, scr, r, F.lane);
                else { r -= I_OIN; p0_transpose_item(P.in[I_OWOUT] + (size_t)i * 1024 * 1024, 1024, 1024, 0, 32, WSP(h16, WS_WOOUT + (size_t)i * SZ_WOUT), 0, scr, r, F.lane); }
            }
        }
    }
}

__device__ __forceinline__ void norm_phase(Frame& F, int l, bool with_ctx) {
    const Params& P = *F.p;
    const int gw = F.vcu * 8 + F.wave, NGW = F.G * 8, lane = F.lane;
    const int nrows = with_ctx ? NTOK : NLAT;
    const float* ng = P.in[I_NORMG] + (size_t)l * 1024;
    const float* ada = WSP(float, WS_ADA) + (size_t)l * 9 * 3072;
    h16* H = WSP(h16, WS_H);
    for (int r0 = gw * 2; r0 < nrows; r0 += NGW * 2) {
        const bool lat = r0 < NLAT; const int br = lat ? (r0 >> 11) : 8;
        f32x4 v[2][4];
        if (l == 0) {
            if (lat) {
#pragma unroll
                for (int q = 0; q < 2; ++q) { const int r = r0 + q, t = r & 2047; const f32x4* xr = (const f32x4*)(P.in[I_X] + (size_t)r * 1024) + lane;
                    const f32x4* rt = (const f32x4*)(WSP(float, WS_POS) + (size_t)(t >> 6) * 512) + lane; const f32x4* ct = (const f32x4*)(WSP(float, WS_POS) + (size_t)(32 + (t & 63)) * 512) + lane;
                    v[q][0] = xr[0] + rt[0]; v[q][1] = xr[64] + rt[64]; v[q][2] = xr[128] + ct[0]; v[q][3] = xr[192] + ct[64]; }
#pragma unroll
                for (int q = 0; q < 2; ++q) { f32x4* xo = (f32x4*)(P.out + (size_t)(r0 + q) * 1024) + lane;
#pragma unroll
                    for (int j = 0; j < 4; ++j) xo[64 * j] = v[q][j]; }
            } else {
#pragma unroll
                for (int q = 0; q < 2; ++q) { const f32x4* xr = (const f32x4*)(P.in[I_CTX] + (size_t)(r0 + q - NLAT) * 1024) + lane;
#pragma unroll
                    for (int j = 0; j < 4; ++j) v[q][j] = xr[64 * j]; }
#pragma unroll
                for (int q = 0; q < 2; ++q) { f32x4* xo = (f32x4*)(WSP(float, WS_XC) + (size_t)(r0 + q - NLAT) * 1024) + lane;
#pragma unroll
                    for (int j = 0; j < 4; ++j) xo[64 * j] = v[q][j]; } }
        } else {
#pragma unroll
            for (int q = 0; q < 2; ++q) { const int r = r0 + q; const f32x4* xr = (lat ? (const f32x4*)(P.out + (size_t)r * 1024) : (const f32x4*)(WSP(float, WS_XC) + (size_t)(r - NLAT) * 1024)) + lane;
#pragma unroll
                for (int j = 0; j < 4; ++j) v[q][j] = xr[64 * j]; } }
        const f32x4* g4 = (const f32x4*)ng + lane; const f32x4* sh4 = (const f32x4*)(ada + (size_t)br * 3072) + lane; const f32x4* sc4 = (const f32x4*)(ada + (size_t)br * 3072 + 1024) + lane;
        f32x4 gs[4], sh[4];
#pragma unroll
        for (int j = 0; j < 4; ++j) { gs[j] = g4[64 * j] * (sc4[64 * j] + 1.0f); sh[j] = sh4[64 * j]; }
#pragma unroll
        for (int q = 0; q < 2; ++q) {
            float s = 0.f;
#pragma unroll
            for (int j = 0; j < 4; ++j) s += (v[q][j].x * v[q][j].x + v[q][j].y * v[q][j].y) + (v[q][j].z * v[q][j].z + v[q][j].w * v[q][j].w);
            const float rstd = 1.0f / sqrtf(wave_sum(s, lane) * (1.0f / 1024.0f) + 1e-6f);
            u32x2* o8 = (u32x2*)(H + (size_t)(r0 + q) * 1024) + lane;
#pragma unroll
            for (int j = 0; j < 4; ++j) { const f32x4 y = v[q][j] * rstd * gs[j] + sh[j]; u32x2 o; o.x = pkh(y.x, y.y); o.y = pkh(y.z, y.w); o8[64 * j] = o; }
        }
    }
}
__device__ __forceinline__ void final_norm_phase(Frame& F) {
    const Params& P = *F.p;
    const int gw = F.vcu * 8 + F.wave, NGW = F.G * 8, lane = F.lane;
    const f32x4* g4 = (const f32x4*)P.in[I_FINALG] + lane;
    for (int r = gw; r < NLAT; r += NGW) {
        f32x4* xr = (f32x4*)(P.out + (size_t)r * 1024) + lane; f32x4 v[4]; float s = 0.f;
#pragma unroll
        for (int j = 0; j < 4; ++j) { v[j] = xr[64 * j]; s += (v[j].x * v[j].x + v[j].y * v[j].y) + (v[j].z * v[j].z + v[j].w * v[j].w); }
        const float rstd = 1.0f / sqrtf(wave_sum(s, lane) * (1.0f / 1024.0f) + 1e-6f);
#pragma unroll
        for (int j = 0; j < 4; ++j) xr[64 * j] = v[j] * rstd * g4[64 * j];
    }
}

struct Sched3 {
    const char* A0; const char* B0; int nM0, nN0;
    const char* A1; const char* B1; int nM1, nN1;
    const char* A2; const char* B2; int nM2, nN2;
    int G, c, lda, ldb;
    __device__ __forceinline__ bool next(int i, Unit& u) const {
        int L = i * G + c; int pm, pn;
        const int n0 = nM0 * nN0, n1 = nM1 * nN1, n2 = nM2 * nN2;
        if (L < n0) { pg8::tile_of(pg8::xcd_remap(L, n0), nM0, nN0, pm, pn); u.job = 0; u.pm = pm; u.pn = pn; u.aux = 0; u.a = A0 + (size_t)pm * 512 * lda; u.b = B0 + (size_t)pn * 512 * ldb; return true; }
        L -= n0;
        if (L < n1) { pg8::tile_of(pg8::xcd_remap(L, n1), nM1, nN1, pm, pn); u.job = 1; u.pm = pm; u.pn = pn; u.aux = 0; u.a = A1 + (size_t)pm * 512 * lda; u.b = B1 + (size_t)pn * 512 * ldb; return true; }
        L -= n1;
        if (L < n2) { pg8::tile_of(pg8::xcd_remap(L, n2), nM2, nN2, pm, pn); u.job = 2; u.pm = pm; u.pn = pn; u.aux = 0; u.a = A2 + (size_t)pm * 512 * lda; u.b = B2 + (size_t)pn * 512 * ldb; return true; }
        return false;
    }
};
struct SchedS5 {
    const char* UA; const char* W; size_t wstride; int nMt, G, c;
    __device__ __forceinline__ bool next(int i, Unit& u) const {
        const int L = i * G + c, n = NGRP * nMt; if (L >= n) return false;
        const int w = pg8::xcd_remap(L, n), g = w / nMt, pm = w % nMt;
        u.job = 0; u.pm = pm; u.pn = 0; u.aux = g; u.a = UA + ((size_t)g * UA_ROWS + (size_t)pm * 256) * UA_LD * 2; u.b = W + (size_t)g * wstride; return true;
    }
};

#define EPI_ROWS_BEGIN  _Pragma("unroll") for (int ai = 0; ai < 2; ++ai) _Pragma("unroll") for (int m = 0; m < 4; ++m) { const int rl = ai * 128 + wr * 64 + m * 16;
#define EPI_ROWS_END    asm volatile("" ::: "memory"); }

struct EpiEvenIn {
    h16* UA; h16* SZ; h16* ZT; h16* YB;
    __device__ __forceinline__ void operator()(const Acc& acc, const Unit& u, int wr, int wc, int fr, int fq) const {
        if (u.job < 2) {
            const int tile = (u.job == 0) ? u.pm : 64 + u.pm;
            EPI_ROWS_BEGIN
                const int r16 = tile * 256 + rl;
                int crow; if (u.job == 0) crow = (r16 >> 11) * 128 + ((r16 & 2047) >> 4); else { const int rc = r16 - NLAT; crow = 1024 + (rc >> 8) * 16 + ((rc & 255) >> 4); }
#pragma unroll
                for (int bj = 0; bj < 2; ++bj) { const int c0 = u.pn * 256 + bj * 128 + wc * 32 + 8 * fq; const f32x4 v0 = acc[ai][bj][m][0], v1 = acc[ai][bj][m][1]; u32x4 w;
                    if (u.pn < 3) { w.x = pkh(v0[0], v0[1]); w.y = pkh(v0[2], v0[3]); w.z = pkh(v1[0], v1[1]); w.w = pkh(v1[2], v1[3]);
                        const int g = c0 >> 4, h0 = c0 & 15;
                        *(u32x4*)(UA + ((size_t)g * UA_ROWS + crow) * UA_LD + fr * 16 + h0) = w;
                    } else { w.x = pkh(siluf_(v0[0]), siluf_(v0[1])); w.y = pkh(siluf_(v0[2]), siluf_(v0[3])); w.z = pkh(siluf_(v1[0]), siluf_(v1[1])); w.w = pkh(siluf_(v1[2]), siluf_(v1[3]));
                        *(u32x4*)(SZ + (size_t)(r16 + fr) * 1024 + (c0 - 768)) = w; } }
            EPI_ROWS_END
        } else {
            EPI_ROWS_BEGIN
                const int ch = rl + fr;
#pragma unroll
                for (int bj = 0; bj < 2; ++bj) { const int cl = bj * 128 + wc * 32 + 8 * fq; f32x4 v0 = acc[ai][bj][m][0], v1 = acc[ai][bj][m][1]; u32x4 w;
                    if (u.pn < 64) { w.x = pkh(v0[0], v0[1]); w.y = pkh(v0[2], v0[3]); w.z = pkh(v1[0], v1[1]); w.w = pkh(v1[2], v1[3]);
                        *(u32x4*)(ZT + (size_t)(u.pm * 256 + ch) * NLAT + u.pn * 256 + cl) = w;
                    } else { if (u.pm) { v0 = -v0; v1 = -v1; } w.x = pkh(v0[0], v0[1]); w.y = pkh(v0[2], v0[3]); w.z = pkh(v1[0], v1[1]); w.w = pkh(v1[2], v1[3]);
                        *(u32x4*)(YB + (size_t)(NLAT + (u.pn - 64) * 256 + ch) * 512 + u.pm * 256 + cl) = w; } }
            EPI_ROWS_END
        }
    }
};
struct EpiS5E {
    h16* UA;
    __device__ __forceinline__ void operator()(const Acc& acc, const Unit& u, int wr, int wc, int fr, int fq) const {
        EPI_ROWS_BEGIN
            const int row = u.pm * 256 + rl + fr;
#pragma unroll
            for (int bj = 0; bj < 2; ++bj) { const int c0 = bj * 128 + wc * 32 + 8 * fq; const f32x4 v0 = acc[ai][bj][m][0], v1 = acc[ai][bj][m][1]; u32x4 w;
                w.x = pkh(v0[0], v0[1]); w.y = pkh(v0[2], v0[3]); w.z = pkh(v1[0], v1[1]); w.w = pkh(v1[2], v1[3]);
                *(u32x4*)(UA + ((size_t)u.aux * UA_ROWS + row) * UA_LD + 256 + c0) = w; }
        EPI_ROWS_END
    }
};
struct EpiS5Y {
    h16* YA;
    __device__ __forceinline__ void operator()(const Acc& acc, const Unit& u, int wr, int wc, int fr, int fq) const {
        EPI_ROWS_BEGIN
            const int row = u.pm * 256 + rl + fr;
            int tok0; bool ok = true;
            if (row < 1024) tok0 = (row >> 7) * 2048 + (row & 127) * 16; else if (row < 1152) { const int rc = row - 1024; tok0 = NLAT + (rc >> 4) * 256 + (rc & 15) * 16; } else { tok0 = 0; ok = false; }
            if (ok) {
#pragma unroll
                for (int bj = 0; bj < 2; ++bj) { const int c0 = bj * 128 + wc * 32 + 8 * fq, k = c0 >> 4, h0 = c0 & 15; const f32x4 v0 = acc[ai][bj][m][0] * (1.0f / SIG2), v1 = acc[ai][bj][m][1] * (1.0f / SIG2); u32x4 w;
                    w.x = pkh(gelu_tanh_(v0[0]), gelu_tanh_(v0[1])); w.y = pkh(gelu_tanh_(v0[2]), gelu_tanh_(v0[3])); w.z = pkh(gelu_tanh_(v1[0]), gelu_tanh_(v1[1])); w.w = pkh(gelu_tanh_(v1[2]), gelu_tanh_(v1[3]));
                    *(u32x4*)(YA + (size_t)(tok0 + k) * 768 + u.aux * 16 + h0) = w; } }
        EPI_ROWS_END
    }
};
struct EpiFnetB {
    h16* Y; const h16* SZ;
    __device__ __forceinline__ void operator()(const Acc& acc, const Unit& u, int wr, int wc, int fr, int fq) const {
        const bool lat = u.pn < 64; const float nrm = lat ? 0.0027621358640099515f : 0.0078125f;
#pragma unroll
        for (int ai = 0; ai < 2; ++ai) {
            u32x4 zv[4][2];
#pragma unroll
            for (int m = 0; m < 4; ++m) { const int k2 = ai * 128 + wr * 64 + m * 16 + fr; const int tok = lat ? ((u.pn >> 3) * 2048 + (u.pn & 7) + 8 * k2) : (NLAT + (u.pn - 64) * 256 + k2);
#pragma unroll
                for (int bj = 0; bj < 2; ++bj) zv[m][bj] = *(const u32x4*)(SZ + (size_t)tok * 1024 + 768 + bj * 128 + wc * 32 + 8 * fq); }
#pragma unroll
            for (int m = 0; m < 4; ++m) { const int k2 = ai * 128 + wr * 64 + m * 16 + fr; const int tok = lat ? ((u.pn >> 3) * 2048 + (u.pn & 7) + 8 * k2) : (NLAT + (u.pn - 64) * 256 + k2);
#pragma unroll
                for (int bj = 0; bj < 2; ++bj) { const int ch = bj * 128 + wc * 32 + 8 * fq; const f32x4 v0 = acc[ai][bj][m][0] * nrm, v1 = acc[ai][bj][m][1] * nrm;
                    const u32x4 z = zv[m][bj]; u32x4 w;
                    const f32x2 z0 = unpkh(z.x), z1 = unpkh(z.y), z2 = unpkh(z.z), z3 = unpkh(z.w);
                    w.x = pkh(v0[0] * z0.x, v0[1] * z0.y); w.y = pkh(v0[2] * z1.x, v0[3] * z1.y); w.z = pkh(v1[0] * z2.x, v1[1] * z2.y); w.w = pkh(v1[2] * z3.x, v1[3] * z3.y);
                    *(u32x4*)(Y + (size_t)tok * 1024 + 768 + ch) = w; } }
            asm volatile("" ::: "memory");
        }
    }
};
struct EpiGlu {
    h16* Y; const h16* YA; const h16* SZ; const float* bias;
    __device__ __forceinline__ void operator()(const Acc& acc, const Unit& u, int wr, int wc, int fr, int fq) const {
        const int tile = (u.job == 0) ? u.pm : 64 + u.pm;
        f32x4 bv[2][2];
#pragma unroll
        for (int bj = 0; bj < 2; ++bj)
#pragma unroll
            for (int n = 0; n < 2; ++n) bv[bj][n] = *(const f32x4*)(bias + u.pn * 256 + bj * 128 + wc * 32 + 8 * fq + 4 * n);
#pragma unroll
        for (int ah = 0; ah < 4; ++ah) { const int ai = ah >> 1, m0 = (ah & 1) * 2;
            u32x4 av[4][2], zv[4][2];
#pragma unroll
            for (int m = m0; m < m0 + 2; ++m) { const size_t r = (size_t)tile * 256 + ai * 128 + wr * 64 + m * 16 + fr;
#pragma unroll
                for (int bj = 0; bj < 2; ++bj) { const int c0 = u.pn * 256 + bj * 128 + wc * 32 + 8 * fq; av[m][bj] = *(const u32x4*)(YA + r * 768 + c0); zv[m][bj] = *(const u32x4*)(SZ + r * 1024 + c0); } }
#pragma unroll
            for (int m = m0; m < m0 + 2; ++m) { const size_t r = (size_t)tile * 256 + ai * 128 + wr * 64 + m * 16 + fr;
#pragma unroll
                for (int bj = 0; bj < 2; ++bj) { const int c0 = u.pn * 256 + bj * 128 + wc * 32 + 8 * fq; const f32x4 v0 = acc[ai][bj][m][0] + bv[bj][0], v1 = acc[ai][bj][m][1] + bv[bj][1];
                    const u32x4 a = av[m][bj], z = zv[m][bj]; u32x4 w;
                    const f32x2 a0 = unpkh(a.x), a1 = unpkh(a.y), a2 = unpkh(a.z), a3 = unpkh(a.w), z0 = unpkh(z.x), z1 = unpkh(z.y), z2 = unpkh(z.z), z3 = unpkh(z.w);
                    w.x = pkh(a0.x * sigmoidf_(v0[0]) * z0.x, a0.y * sigmoidf_(v0[1]) * z0.y); w.y = pkh(a1.x * sigmoidf_(v0[2]) * z1.x, a1.y * sigmoidf_(v0[3]) * z1.y);
                    w.z = pkh(a2.x * sigmoidf_(v1[0]) * z2.x, a2.y * sigmoidf_(v1[1]) * z2.y); w.w = pkh(a3.x * sigmoidf_(v1[2]) * z3.x, a3.y * sigmoidf_(v1[3]) * z3.y);
                    *(u32x4*)(Y + r * 1024 + c0) = w; } }
            asm volatile("" ::: "memory");
        }
    }
};
struct EpiOut {
    float* XL; float* XC; const float* ada;
    __device__ __forceinline__ void operator()(const Acc& acc, const Unit& u, int wr, int wc, int fr, int fq) const {
        const int br = (u.job == 0) ? (u.pm >> 3) : 8;
        float* X = (u.job == 0) ? XL : XC;
        f32x4 gv[2][2];
#pragma unroll
        for (int bj = 0; bj < 2; ++bj)
#pragma unroll
            for (int n = 0; n < 2; ++n) gv[bj][n] = *(const f32x4*)(ada + (size_t)br * 3072 + 2048 + u.pn * 256 + bj * 128 + wc * 32 + 8 * fq + 4 * n);
#pragma unroll
        for (int ah = 0; ah < 4; ++ah) { const int ai = ah >> 1, m0 = (ah & 1) * 2;
            f32x4 xv[4][2][2];
#pragma unroll
            for (int m = m0; m < m0 + 2; ++m) { const float* rowp = X + ((size_t)u.pm * 256 + ai * 128 + wr * 64 + m * 16 + fr) * 1024 + u.pn * 256 + wc * 32 + 8 * fq;
#pragma unroll
                for (int bj = 0; bj < 2; ++bj)
#pragma unroll
                    for (int n = 0; n < 2; ++n) xv[m][bj][n] = *(const f32x4*)(rowp + bj * 128 + 4 * n); }
#pragma unroll
            for (int m = m0; m < m0 + 2; ++m) { float* rowp = X + ((size_t)u.pm * 256 + ai * 128 + wr * 64 + m * 16 + fr) * 1024 + u.pn * 256 + wc * 32 + 8 * fq;
#pragma unroll
                for (int bj = 0; bj < 2; ++bj)
#pragma unroll
                    for (int n = 0; n < 2; ++n) *(f32x4*)(rowp + bj * 128 + 4 * n) = xv[m][bj][n] + gv[bj][n] * acc[ai][bj][m][n]; }
            asm volatile("" ::: "memory");
        }
    }
};
struct EpiOddIn {
    h16* Pb; h16* SZ;
    __device__ __forceinline__ void operator()(const Acc& acc, const Unit& u, int wr, int wc, int fr, int fq) const {
        const int tile = (u.job == 0) ? u.pm : 64 + u.pm;
        EPI_ROWS_BEGIN
            const size_t r = (size_t)tile * 256 + rl + fr;
#pragma unroll
            for (int bj = 0; bj < 2; ++bj) { const int c0 = u.pn * 256 + bj * 128 + wc * 32 + 8 * fq; const f32x4 v0 = acc[ai][bj][m][0], v1 = acc[ai][bj][m][1]; u32x4 w;
                if (u.pn < 8) { w.x = pkh(v0[0], v0[1]); w.y = pkh(v0[2], v0[3]); w.z = pkh(v1[0], v1[1]); w.w = pkh(v1[2], v1[3]); *(u32x4*)(Pb + r * 2048 + c0) = w; }
                else { w.x = pkh(siluf_(v0[0]), siluf_(v0[1])); w.y = pkh(siluf_(v0[2]), siluf_(v0[3])); w.z = pkh(siluf_(v1[0]), siluf_(v1[1])); w.w = pkh(siluf_(v1[2]), siluf_(v1[3]));
                    *(u32x4*)(SZ + r * 1024 + (c0 - 2048)) = w; } }
        EPI_ROWS_END
    }
};

__device__ __forceinline__ void fnet_stage_a(Frame& F) {
    const h16* ZT = WSP(h16, WS_ZT); h16* YB = WSP(h16, WS_YB);
    constexpr float RS = 0.70710678118654752f;
    const float c8[8] = {1.f, RS, 0.f, -RS, -1.f, -RS, 0.f, RS}, s8[8] = {0.f, RS, 1.f, RS, 0.f, -RS, -1.f, -RS};
    for (int it = F.vcu; it < 256; it += F.G) {
        const int e = it * 512 + F.tid, tq = e & 63, ch = (e >> 6) & 255, b = e >> 14, t2 = tq * 4;
        float zr[8][4], zi[8][4];
        u32x2 ra[8], rs[8];
#pragma unroll
        for (int t1 = 0; t1 < 8; ++t1) { const size_t o = (size_t)b * 2048 + 256 * t1 + t2; ra[t1] = *(const u32x2*)(ZT + (size_t)ch * NLAT + o); rs[t1] = *(const u32x2*)(ZT + (size_t)(256 + ch) * NLAT + o); }
#pragma unroll
        for (int t1 = 0; t1 < 8; ++t1) { const f32x2 a0 = unpkh(ra[t1].x), a1 = unpkh(ra[t1].y), s0 = unpkh(rs[t1].x), s1 = unpkh(rs[t1].y);
            zr[t1][0] = a0.x; zr[t1][1] = a0.y; zr[t1][2] = a1.x; zr[t1][3] = a1.y; zi[t1][0] = -s0.x; zi[t1][1] = -s0.y; zi[t1][2] = -s1.x; zi[t1][3] = -s1.y; }
#pragma unroll
        for (int k1 = 0; k1 < 8; ++k1) {
            float yr[4] = {0.f, 0.f, 0.f, 0.f}, yi[4] = {0.f, 0.f, 0.f, 0.f};
#pragma unroll
            for (int t1 = 0; t1 < 8; ++t1) { const float cw = c8[(k1 * t1) & 7], sw = s8[(k1 * t1) & 7];
#pragma unroll
                for (int q = 0; q < 4; ++q) { yr[q] += zr[t1][q] * cw + zi[t1][q] * sw; yi[q] += zi[t1][q] * cw - zr[t1][q] * sw; } }
            float o_re[4], o_im[4];
#pragma unroll
            for (int q = 0; q < 4; ++q) { float sn, cs; sincospif((float)(k1 * (t2 + q)) * (1.0f / 1024.0f), &sn, &cs);
                o_re[q] = yr[q] * cs + yi[q] * sn; o_im[q] = yi[q] * cs - yr[q] * sn; }
            h16* dst = YB + (size_t)((b * 8 + k1) * 256 + ch) * 512 + t2;
            u32x2 wre, wim; wre.x = pkh(o_re[0], o_re[1]); wre.y = pkh(o_re[2], o_re[3]); wim.x = pkh(o_im[0], o_im[1]); wim.y = pkh(o_im[2], o_im[3]);
            *(u32x2*)dst = wre; *(u32x2*)(dst + 256) = wim;
        }
    }
}
__device__ __forceinline__ void s5_scan(Frame& F, int i, int first_block, bool dummy) {
    int vb = F.bx - first_block; if (vb < 0) vb += F.G;
    for (int it = vb; it < 96; it += F.G) {
        const int tid = F.tid, p = tid & 63, dir = (tid >> 6) & 1, pr = it * 4 + (tid >> 7), b = pr / NGRP, g = pr % NGRP;
        const f32x2 lw = WSP(f32x2, WS_LAM)[(((size_t)i * 2 + dir) * NGRP + g) * 64 + p];
        h16* base = WSP(h16, WS_UA) + (size_t)g * UA_ROWS * UA_LD + 256 + dir * 128 + 2 * p;
        const ptrdiff_t wofs = dummy ? (WSP(h16, WS_ZT) + (size_t)(g % 12) * UA_ROWS * UA_LD) - (WSP(h16, WS_UA) + (size_t)g * UA_ROWS * UA_LD) : 0;
#define SCAN_ROW(k, q) ((k) == 0 ? (1024 + b * 16 + (dir == 0 ? (q) : 15 - (q))) : (b * 128 + (dir == 0 ? ((k) - 1) * 16 + (q) : 127 - (((k) - 1) * 16 + (q)))))
        float sr = 0.f, si = 0.f;
        unsigned ev[16], nv[16];
#pragma unroll
        for (int q = 0; q < 16; ++q) ev[q] = *(const unsigned*)(base + (size_t)SCAN_ROW(0, q) * UA_LD);
#pragma unroll 1
        for (int k = 0; k < 9; ++k) {
            if (k < 8) {
#pragma unroll
                for (int q = 0; q < 16; ++q) nv[q] = *(const unsigned*)(base + (size_t)SCAN_ROW(k + 1, q) * UA_LD); }
#pragma unroll
            for (int q = 0; q < 16; ++q) { const f32x2 e = unpkh(ev[q]);
                *(unsigned*)(base + wofs + (size_t)SCAN_ROW(k, q) * UA_LD) = pkh(sr, si);
                const float nr = lw.x * sr - lw.y * si + e.x, ni = lw.x * si + lw.y * sr + e.y; sr = nr; si = ni; }
#pragma unroll
            for (int q = 0; q < 16; ++q) ev[q] = nv[q];
        }
#undef SCAN_ROW
    }
}
__device__ __forceinline__ void unpk8(const u32x4 v, float (&o)[8]) { const f32x2 a = unpkh(v.x), b = unpkh(v.y), c = unpkh(v.z), d = unpkh(v.w); o[0] = a.x; o[1] = a.y; o[2] = b.x; o[3] = b.y; o[4] = c.x; o[5] = c.y; o[6] = d.x; o[7] = d.y; }
template <int HW>
__device__ __forceinline__ void pool_seg(const h16* Pb, const h16* SZ, h16* Y, int r0, int s0, int s1, int cofs) {
    constexpr int NR = 8 + 2 * HW;
    u32x4 rows[NR];
#pragma unroll
    for (int q = 0; q < NR; ++q) { int r = r0 - HW + q; r = r < s0 ? s0 : (r >= s1 ? s1 - 1 : r); rows[q] = *(const u32x4*)(Pb + (size_t)r * 2048 + cofs); }
    float sum[8];
#pragma unroll
    for (int c = 0; c < 8; ++c) sum[c] = 0.f;
#pragma unroll
    for (int q = 0; q < 2 * HW; ++q) { const int r = r0 - HW + q; const float ok = (r >= s0 && r < s1) ? 1.f : 0.f; float t[8]; unpk8(rows[q], t);
#pragma unroll
        for (int c = 0; c < 8; ++c) sum[c] += t[c] * ok; }
#pragma unroll
    for (int j = 0; j < 8; ++j) {
        const int r = r0 + j; const int lo = max(r - HW, s0), hi = min(r + HW, s1); const float inv = 1.0f / (float)(hi - lo);
        float me[8], z[8], o[8]; unpk8(rows[j + HW], me); unpk8(*(const u32x4*)(SZ + (size_t)r * 1024 + cofs), z);
#pragma unroll
        for (int c = 0; c < 8; ++c) o[c] = (sum[c] * inv - me[c]) * z[c];
        u32x4 w; w.x = pkh(o[0], o[1]); w.y = pkh(o[2], o[3]); w.z = pkh(o[4], o[5]); w.w = pkh(o[6], o[7]);
        *(u32x4*)(Y + (size_t)r * 1024 + cofs) = w;
        if (j < 7) { const float oka = (r + HW < s1) ? 1.f : 0.f, okd = (r - HW >= s0) ? 1.f : 0.f; float ta[8], td[8]; unpk8(rows[j + 2 * HW], ta); unpk8(rows[j], td);
#pragma unroll
            for (int c = 0; c < 8; ++c) sum[c] += ta[c] * oka - td[c] * okd; }
    }
}
__device__ __forceinline__ void conv_seg(const h16* Pb, const h16* SZ, h16* Y, const float* cw, int r0, int s0, int s1, int c8) {
    u32x4 cg[10], xp[10];
#pragma unroll
    for (int q = 0; q < 10; ++q) { int r = r0 - 1 + q; r = r < s0 ? s0 : (r >= s1 ? s1 - 1 : r); cg[q] = *(const u32x4*)(Pb + (size_t)r * 2048 + 512 + c8); xp[q] = *(const u32x4*)(Pb + (size_t)r * 2048 + 1024 + c8); }
    float w0[8], w1[8], w2[8];
#pragma unroll
    for (int q = 0; q < 8; ++q) { w0[q] = cw[c8 + q]; w1[q] = cw[512 + c8 + q]; w2[q] = cw[1024 + c8 + q]; }
    float vm[8], vc[8], vp[8];
    { float a[8], b[8]; const float ok = (r0 - 1 >= s0) ? 1.f : 0.f; unpk8(cg[0], a); unpk8(xp[0], b);
#pragma unroll
      for (int c = 0; c < 8; ++c) vm[c] = a[c] * b[c] * ok;
      unpk8(cg[1], a); unpk8(xp[1], b);
#pragma unroll
      for (int c = 0; c < 8; ++c) vc[c] = a[c] * b[c]; }
#pragma unroll
    for (int j = 0; j < 8; ++j) {
        const int r = r0 + j; { float a[8], b[8]; const float ok = (r + 1 < s1) ? 1.f : 0.f; unpk8(cg[j + 2], a); unpk8(xp[j + 2], b);
#pragma unroll
            for (int c = 0; c < 8; ++c) vp[c] = a[c] * b[c] * ok; }
        float gg[8], z[8], o[8]; unpk8(*(const u32x4*)(Pb + (size_t)r * 2048 + 1536 + c8), gg); unpk8(*(const u32x4*)(SZ + (size_t)r * 1024 + 512 + c8), z);
#pragma unroll
        for (int c = 0; c < 8; ++c) { o[c] = gg[c] * (vm[c] * w0[c] + vc[c] * w1[c] + vp[c] * w2[c]) * z[c]; vm[c] = vc[c]; vc[c] = vp[c]; }
        u32x4 w; w.x = pkh(o[0], o[1]); w.y = pkh(o[2], o[3]); w.z = pkh(o[4], o[5]); w.w = pkh(o[6], o[7]);
        *(u32x4*)(Y + (size_t)r * 1024 + 512 + c8) = w;
    }
}
__device__ __forceinline__ void odd_mix_phase(Frame& F, int i, bool with_ctx) {
    const Params& Pm = *F.p;
    const h16* Pb = WSP(h16, WS_P); const h16* SZ = WSP(h16, WS_SZ); h16* Y = WSP(h16, WS_H);
    const float* cw = Pm.in[I_CONVW] + (size_t)i * 3 * 512;
    const int nrows = with_ctx ? NTOK : NLAT, npool = (nrows / 32) * 4, nconv = nrows / 8;
    const int gw = F.vcu * 8 + F.wave, NGW = F.G * 8, lane = F.lane;
    for (int it = gw; it < npool + nconv; it += NGW) {
        if (it < npool) {
            const int gi = it & 3, r0 = (it >> 2) * 32 + (lane >> 4) * 8, cofs = gi * 128 + (lane & 15) * 8;
            const bool lat = r0 < NLAT; const int s0 = lat ? (r0 & ~2047) : (NLAT + ((r0 - NLAT) & ~255)), s1 = s0 + (lat ? 2048 : 256);
            if (gi == 0) pool_seg<1>(Pb, SZ, Y, r0, s0, s1, cofs); else if (gi == 1) pool_seg<2>(Pb, SZ, Y, r0, s0, s1, cofs);
            else if (gi == 2) pool_seg<4>(Pb, SZ, Y, r0, s0, s1, cofs); else pool_seg<8>(Pb, SZ, Y, r0, s0, s1, cofs);
        } else {
            const int r0 = (it - npool) * 8;
            const bool lat = r0 < NLAT; const int s0 = lat ? (r0 & ~2047) : (NLAT + ((r0 - NLAT) & ~255)), s1 = s0 + (lat ? 2048 : 256);
            conv_seg(Pb, SZ, Y, cw, r0, s0, s1, lane * 8);
        }
    }
}

enum { PT_PROLOGUE = 0, PT_NORM, PT_EIN, PT_S5E, PT_SCAN, PT_S5Y, PT_GLU, PT_OUT, PT_OIN, PT_OMIX, PT_FINAL };
__device__ __forceinline__ void decode_phase(int ph, int& type, int& l) {
    if (ph == 0) { type = PT_PROLOGUE; l = 0; return; }
    if (ph == N_PHASES - 1) { type = PT_FINAL; l = 3; return; }
    int q = ph - 1;
    if (q < 7) { l = 0; type = PT_NORM + q; return; } q -= 7;
    if (q < 4) { l = 1; type = (q == 0) ? PT_NORM : (q == 1) ? PT_OIN : (q == 2) ? PT_OMIX : PT_OUT; return; } q -= 4;
    if (q < 7) { l = 2; type = PT_NORM + q; return; } q -= 7;
    l = 3; type = (q == 0) ? PT_NORM : (q == 1) ? PT_OIN : (q == 2) ? PT_OMIX : PT_OUT;
}

__global__ void __launch_bounds__(512, 2) fwd_kernel(Params prm) {
    extern __shared__ __attribute__((aligned(16))) unsigned char lds_raw[];
    Frame F;
    F.lds = (LAS unsigned char*)lds_raw;
    F.tid = threadIdx.x; F.lane = F.tid & 63; F.wave = __builtin_amdgcn_readfirstlane(F.tid >> 6);
    F.G = gridDim.x; F.bx = blockIdx.x; { const int bx = blockIdx.x; F.vcu = (F.G % 8 == 0) ? (bx % 8) * (F.G / 8) + bx / 8 : bx; }
    F.p = &prm; F.ws = prm.ws;
    volatile LAS unsigned* MISC = (volatile LAS unsigned*)(F.lds + MISC_OFF);
    if (F.tid < 64) MISC[F.tid] = 0u;
    __syncthreads();
    XcdBarrier bar; bar.bar = (unsigned*)(F.ws + WS_CTL) + 4096; bar.x = 0; bar.st = nullptr;
    if (prm.ph_hi - prm.ph_lo > 1) bar = xcd_barrier_post((unsigned*)(F.ws + WS_CTL) + 4096, MISC + 8, F.tid == 0);

    const int wave_s = F.wave;
    for (int ph_ = prm.ph_lo; ph_ < prm.ph_hi; ++ph_) {
      int type0_, l0_; decode_phase(ph_, type0_, l0_);
      const int nrep_ = (PROBE_TYPE >= 0 && type0_ == PROBE_TYPE) ? 1 + PROBE_REP : 1;
      for (int rep_ = 0; rep_ < nrep_; ++rep_) {
        const int ph = __builtin_amdgcn_readfirstlane(ph_);
        const bool dummy = (rep_ + 1 < nrep_);
        int type, l; decode_phase(ph, type, l);
        const int i = l >> 1;
        {
#define REFRESH_LANE() do { int wv_ = wave_s; asm volatile("" : "+s"(wv_)); \
            int ln_; asm volatile("v_mbcnt_lo_u32_b32 %0, -1, 0\n\tv_mbcnt_hi_u32_b32 %0, -1, %0" : "=v"(ln_)); \
            const int tid_ = wv_ * 64 + ln_; F.tid = tid_; F.lane = ln_; F.wave = wv_; } while (0)
            REFRESH_LANE();
            unsigned zero_ = 0u; asm volatile("" : "+s"(zero_));
            int bx_ = blockIdx.x; asm volatile("" : "+s"(bx_)); F.bx = bx_; F.G = gridDim.x; F.vcu = (F.G % 8 == 0) ? (bx_ % 8) * (F.G / 8) + bx_ / 8 : bx_;
            F.ws = prm.ws + zero_; F.p = (const Params*)((const char*)&prm + zero_);
        }
        const bool need_ctx = (l < 2);
        const bool ctx_in = (l < 3);
#ifndef PH_MASK
#define PH_MASK 0xFFFF
#endif
#ifdef PH_MASK
        if (!((PH_MASK >> type) & 1)) continue;
#endif
        switch (type) {
        case PT_PROLOGUE: p0_prologue(F); break;
        case PT_NORM: norm_phase(F, l, ctx_in); break;
        case PT_FINAL: final_norm_phase(F); break;
        case PT_EIN: {
            Sched3 S; S.G = F.G; S.c = F.bx; S.lda = 1024; S.ldb = 1024;
            const char* H = (const char*)WSP(h16, WS_H); const char* W = (const char*)WSP(h16, WS_WEIN + (size_t)i * SZ_WEIN);
            S.A0 = H; S.B0 = W; S.nM0 = 64; S.nN0 = 7;
            S.A1 = H + (size_t)NLAT * 2048; S.B1 = W; S.nM1 = 8; S.nN1 = need_ctx ? 7 : 3;
            S.A2 = (const char*)WSP(h16, WS_WZ + (size_t)i * SZ_WZ); S.B2 = H; S.nM2 = 2; S.nN2 = need_ctx ? 72 : 64;
            EpiEvenIn E{WSP(h16, WS_UA), WSP(h16, WS_SZ), WSP(h16, WS_ZT), WSP(h16, WS_YB)};
            pg8::gemm_phase(F.lds, F.tid, 1024, 1024, 1024, S, E);
        } break;
        case PT_S5E: {
            SchedS5 S; S.UA = (const char*)WSP(h16, WS_UA); S.W = (const char*)WSP(h16, WS_W1 + (size_t)i * SZ_W1); S.wstride = (size_t)256 * 256 * 2; S.nMt = 5; S.G = F.G; S.c = F.bx;
            EpiS5E E{WSP(h16, WS_UA)};
            pg8::gemm_phase(F.lds, F.tid, 256, UA_LD, 256, S, E);
            REFRESH_LANE();
            fnet_stage_a(F);
        } break;
        case PT_SCAN: {
            Sched3 S; S.G = F.G; S.c = F.bx; S.lda = 512; S.ldb = 512;
            S.A0 = (const char*)WSP(h16, WS_WB); S.B0 = (const char*)WSP(h16, WS_YB); S.nM0 = 1; S.nN0 = need_ctx ? 72 : 64;
            S.A1 = S.A0; S.B1 = S.B0; S.nM1 = 0; S.nN1 = 0; S.A2 = S.A0; S.B2 = S.B0; S.nM2 = 0; S.nN2 = 0;
            EpiFnetB E{WSP(h16, WS_H), WSP(h16, WS_SZ)};
            pg8::gemm_phase(F.lds, F.tid, 512, 512, 512, S, E);
            REFRESH_LANE();
            s5_scan(F, i, 72, dummy);
        } break;
        case PT_S5Y: {
            SchedS5 S; S.UA = (const char*)WSP(h16, WS_UA); S.W = (const char*)WSP(h16, WS_W2 + (size_t)i * SZ_W2); S.wstride = (size_t)256 * 512 * 2; S.nMt = need_ctx ? 5 : 4; S.G = F.G; S.c = F.bx;
            EpiS5Y E{WSP(h16, WS_YA)};
            pg8::gemm_phase(F.lds, F.tid, 512, UA_LD, 512, S, E);
        } break;
        case PT_GLU: {
            Sched3 S; S.G = F.G; S.c = F.bx; S.lda = 768; S.ldb = 768;
            const char* A = (const char*)WSP(h16, WS_YA); const char* W = (const char*)WSP(h16, WS_WGLU + (size_t)i * SZ_WGLU);
            S.A0 = A; S.B0 = W; S.nM0 = 64; S.nN0 = 3; S.A1 = A + (size_t)NLAT * 768 * 2; S.B1 = W; S.nM1 = need_ctx ? 8 : 0; S.nN1 = 3; S.A2 = A; S.B2 = W; S.nM2 = 0; S.nN2 = 0;
            EpiGlu E{WSP(h16, WS_H), WSP(h16, WS_YA), WSP(h16, WS_SZ), F.p->in[I_GLUB] + (size_t)i * 768};
            pg8::gemm_phase(F.lds, F.tid, 768, 768, 768, S, E);
        } break;
        case PT_OUT: {
            Sched3 S; S.G = F.G; S.c = F.bx; S.lda = 1024; S.ldb = 1024;
            const char* A = (const char*)WSP(h16, WS_H); const char* W = (const char*)((l & 1) ? WSP(h16, WS_WOOUT + (size_t)i * SZ_WOUT) : WSP(h16, WS_WEOUT + (size_t)i * SZ_WOUT));
            S.A0 = A; S.B0 = W; S.nM0 = 64; S.nN0 = 4; S.A1 = A + (size_t)NLAT * 2048; S.B1 = W; S.nM1 = need_ctx ? 8 : 0; S.nN1 = 4; S.A2 = A; S.B2 = W; S.nM2 = 0; S.nN2 = 0;
            EpiOut E{dummy ? WSP(float, WS_TMP) : F.p->out, dummy ? WSP(float, WS_TMP) + (size_t)NLAT * D : WSP(float, WS_XC), WSP(float, WS_ADA) + (size_t)l * 9 * 3072};
            pg8::gemm_phase(F.lds, F.tid, 1024, 1024, 1024, S, E);
        } break;
        case PT_OIN: {
            Sched3 S; S.G = F.G; S.c = F.bx; S.lda = 1024; S.ldb = 1024;
            const char* A = (const char*)WSP(h16, WS_H); const char* W = (const char*)WSP(h16, WS_WOIN + (size_t)i * SZ_WOIN);
            S.A0 = A; S.B0 = W; S.nM0 = 64; S.nN0 = 12; S.A1 = A + (size_t)NLAT * 2048; S.B1 = W; S.nM1 = need_ctx ? 8 : 0; S.nN1 = 12; S.A2 = A; S.B2 = W; S.nM2 = 0; S.nN2 = 0;
            EpiOddIn E{WSP(h16, WS_P), WSP(h16, WS_SZ)};
            pg8::gemm_phase(F.lds, F.tid, 1024, 1024, 1024, S, E);
        } break;
        case PT_OMIX: odd_mix_phase(F, i, need_ctx); break;
        default: break;
        }
        if (ph + 1 < prm.ph_hi || dummy) xcd_barrier(bar, F.tid == 0);
      }
    }
}

extern "C" void kernel_launch(void* const* d_in, const int* in_sizes, int n_in, void* d_out, int out_size, void* d_ws, size_t ws_size, hipStream_t stream) {
    static int grid = 0;
    if (grid == 0) {
        if (n_in != 26 || out_size != NLAT * D || ws_size < WS_END) { fprintf(stderr, "kernel_launch: unexpected problem (n_in %d out %d ws %zu need %zu)\n", n_in, out_size, ws_size, (size_t)WS_END); grid = -1; return; }
        int dev = 0, cus = 0, per_cu = 0;
        if (hipGetDevice(&dev) != hipSuccess || hipDeviceGetAttribute(&cus, hipDeviceAttributeMultiprocessorCount, dev) != hipSuccess) { grid = -1; return; }
        if (hipFuncSetAttribute((const void*)fwd_kernel, hipFuncAttributeMaxDynamicSharedMemorySize, LDS_BYTES) != hipSuccess) { fprintf(stderr, "kernel_launch: hipFuncSetAttribute failed\n"); grid = -1; return; }
        if (hipOccupancyMaxActiveBlocksPerMultiprocessor(&per_cu, (const void*)fwd_kernel, 512, LDS_BYTES) != hipSuccess || per_cu < 1) { fprintf(stderr, "kernel_launch: occupancy query says %d\n", per_cu); per_cu = 1; }
        (void)hipGetLastError();
        grid = cus;
        if (grid != 256) fprintf(stderr, "kernel_launch: note: %d CUs\n", grid);
    }
    if (grid < 0) return;
    (void)hipMemsetAsync((char*)d_ws + WS_CTL, 0, CTL_BYTES, stream);
    Params p{};
    for (int i = 0; i < 26; ++i) p.in[i] = (const float*)d_in[i];
    p.out = (float*)d_out; p.ws = (unsigned char*)d_ws;
#if MK_ONE_LAUNCH
    p.ph_lo = 0; p.ph_hi = N_PHASES;
    hipLaunchKernelGGL(fwd_kernel, dim3(grid), dim3(512), LDS_BYTES, stream, p);
#else
    for (int ph = 0; ph < N_PHASES; ++ph) { p.ph_lo = ph; p.ph_hi = ph + 1; hipLaunchKernelGGL(fwd_kernel, dim3(grid), dim3(512), LDS_BYTES, stream, p); }
#endif
}
```
